# Optimizing an MI355X kernel written in HIP

```python
import math
import jax, jax.numpy as jnp
from jax import lax
import numpy as np

D_MODEL = 1024
BATCH = 8
SEQ = 4096
DEPTH = 2

GRID_W = 64
EPS = 1e-6
ROPE_THETA = 10000.0
Q_BLOCK = 128

MLA_HEADS = 6
MLA_NOPE = 64
MLA_ROPE = 32
MLA_V = 64
MLA_QK = MLA_NOPE + MLA_ROPE
Q_LORA = 256
KV_LORA = 128
MLA_WIDTH = MLA_HEADS * MLA_V

NA_HEADS = 6
NA_DIM = 64
NA_WIDTH = NA_HEADS * NA_DIM
NA_KR_MAX = 8
NA_KC = 16

DIFF_HEADS = 4
DIFF_QK = 32
DIFF_V = 2 * DIFF_QK
DIFF_WIDTH = DIFF_HEADS * DIFF_V

MIX_WIDTH = MLA_WIDTH + NA_WIDTH + DIFF_WIDTH

IN_SIZES = (Q_LORA, KV_LORA, MLA_ROPE, 3 * NA_WIDTH, 3 * DIFF_WIDTH, MLA_WIDTH, NA_WIDTH, DIFF_WIDTH)
N_IN = sum(IN_SIZES)
IN_SPLITS = tuple(sum(IN_SIZES[:i + 1]) for i in range(len(IN_SIZES) - 1))

kernel_name = "hybrid_mla_natten_diff_encoder"


def rms_norm(x, g):
    xf = x.astype(jnp.float32)
    y = xf * lax.rsqrt(jnp.mean(xf * xf, axis=-1, keepdims=True) + EPS)
    return (y * g.astype(jnp.float32)).astype(x.dtype)


def rope_tables(seq_len, dim):
    inv = ROPE_THETA ** (-jnp.arange(0, dim, 2, dtype=jnp.float32) / dim)
    ang = jnp.arange(seq_len, dtype=jnp.float32)[:, None] * inv[None, :]
    return jnp.cos(ang), jnp.sin(ang)


def apply_rope(x, cos, sin):
    half = x.shape[-1] // 2
    shape = (1, x.shape[1]) + (1,) * (x.ndim - 3) + (half,)
    cs, sn = cos.reshape(shape), sin.reshape(shape)
    xf = x.astype(jnp.float32)
    x1, x2 = xf[..., :half], xf[..., half:]
    return jnp.concatenate([x1 * cs - x2 * sn, x2 * cs + x1 * sn], axis=-1).astype(x.dtype)


def blocked_attention(q, k, v, scale):
    B, S, H, d = q.shape
    dv = v.shape[-1]
    nb = S // Q_BLOCK
    qb = q.reshape(B, nb, Q_BLOCK, H, d).transpose(1, 0, 2, 3, 4)

    def one(qi):
        s = jnp.einsum('bqhd,bkhd->bhqk', qi, k, preferred_element_type=jnp.float32) * scale
        p = jax.nn.softmax(s, axis=-1)
        return jnp.einsum('bhqk,bkhe->bqhe', p.astype(v.dtype), v)

    out = lax.map(one, qb)
    return out.transpose(1, 0, 2, 3, 4).reshape(B, S, H, dv)


def blocked_diff_attention(q, k, v, lam, scale):
    B, S, H, _, d = q.shape
    dv = v.shape[-1]
    nb = S // Q_BLOCK
    qb = q.reshape(B, nb, Q_BLOCK, H, 2, d).transpose(1, 0, 2, 3, 4, 5)

    def one(qi):
        s = jnp.einsum('bqhnd,bkhnd->bhnqk', qi, k, preferred_element_type=jnp.float32) * scale
        p = jax.nn.softmax(s, axis=-1)
        a = p[:, :, 0] - lam * p[:, :, 1]
        return jnp.einsum('bhqk,bkhe->bqhe', a.astype(v.dtype), v)

    out = lax.map(one, qb)
    return out.transpose(1, 0, 2, 3, 4).reshape(B, S, H, dv)


def neighborhood_attention(q, k, v, rpb, scale):
    B, S, H, d = q.shape
    rows = S // GRID_W
    kr = min(NA_KR_MAX, rows)
    kc = NA_KC
    qg = q.reshape(B, rows, GRID_W, H, d)
    kg = k.reshape(B, rows, GRID_W, H, d)
    vg = v.reshape(B, rows, GRID_W, H, d)
    col = jnp.arange(GRID_W)
    col_start = jnp.clip(col - kc // 2, 0, GRID_W - kc)
    col_idx = col_start[:, None] + jnp.arange(kc)[None, :]
    dc = col_idx - col[:, None] + (NA_KC - 1)

    def one(r):
        r0 = jnp.clip(r - kr // 2, 0, rows - kr)
        q_r = lax.dynamic_index_in_dim(qg, r, axis=1, keepdims=False)
        k_r = lax.dynamic_slice_in_dim(kg, r0, kr, axis=1)[:, :, col_idx]
        v_r = lax.dynamic_slice_in_dim(vg, r0, kr, axis=1)[:, :, col_idx]
        dr = r0 + jnp.arange(kr) - r + (NA_KR_MAX - 1)
        bias = rpb[:, dr[:, None, None], dc[None, :, :]]
        s = jnp.einsum('bchd,brcjhd->bhcrj', q_r, k_r, preferred_element_type=jnp.float32) * scale
        s = s + bias.transpose(0, 2, 1, 3)[None].astype(jnp.float32)
        p = jax.nn.softmax(s.reshape(B, H, GRID_W, kr * kc), axis=-1).reshape(B, H, GRID_W, kr, kc)
        return jnp.einsum('bhcrj,brcjhd->bchd', p.astype(v.dtype), v_r)

    out = lax.map(one, jnp.arange(rows))
    return out.transpose(1, 0, 2, 3, 4).reshape(B, S, H, d)


def hybrid_layer(x, c, layer_idx, ada_w, ada_b, norm_g, w_in, q_lat_g, w_uq, kv_lat_g, w_ukv,
                 mla_q_g, mla_k_g, na_q_g, na_k_g, na_rpb, diff_q_g, diff_k_g,
                 lam_q1, lam_k1, lam_q2, lam_k2, subln_g, w_out,
                 cos_mla, sin_mla, cos_diff, sin_diff):
    B, S, _ = x.shape
    mod = jax.nn.silu(c) @ ada_w + ada_b
    shift, scale, gate = jnp.split(mod, 3, axis=-1)
    h = rms_norm(x, norm_g) * (1.0 + scale[:, None, :]) + shift[:, None, :]

    proj = h @ w_in
    c_q, c_kv, k_pe, na_qkv, diff_qkv, g_mla, g_na, g_diff = jnp.split(proj, IN_SPLITS, axis=-1)

    q = (rms_norm(c_q, q_lat_g) @ w_uq).reshape(B, S, MLA_HEADS, MLA_QK)
    kv = (rms_norm(c_kv, kv_lat_g) @ w_ukv).reshape(B, S, MLA_HEADS, MLA_NOPE + MLA_V)
    k_nope, v_mla = kv[..., :MLA_NOPE], kv[..., MLA_NOPE:]
    k = jnp.concatenate([k_nope, jnp.broadcast_to(k_pe[:, :, None, :], (B, S, MLA_HEADS, MLA_ROPE))], axis=-1)
    q = rms_norm(q, mla_q_g)
    k = rms_norm(k, mla_k_g)
    q = jnp.concatenate([q[..., :MLA_NOPE], apply_rope(q[..., MLA_NOPE:], cos_mla, sin_mla)], axis=-1)
    k = jnp.concatenate([k[..., :MLA_NOPE], apply_rope(k[..., MLA_NOPE:], cos_mla, sin_mla)], axis=-1)
    o_mla = blocked_attention(q, k, v_mla, MLA_QK ** -0.5).reshape(B, S, MLA_WIDTH)

    qn, kn, vn = jnp.split(na_qkv, 3, axis=-1)
    qn = rms_norm(qn.reshape(B, S, NA_HEADS, NA_DIM), na_q_g)
    kn = rms_norm(kn.reshape(B, S, NA_HEADS, NA_DIM), na_k_g)
    vn = vn.reshape(B, S, NA_HEADS, NA_DIM)
    o_na = neighborhood_attention(qn, kn, vn, na_rpb, NA_DIM ** -0.5).reshape(B, S, NA_WIDTH)

    qd, kd, vd = jnp.split(diff_qkv, 3, axis=-1)
    qd = apply_rope(rms_norm(qd.reshape(B, S, DIFF_HEADS, 2, DIFF_QK), diff_q_g), cos_diff, sin_diff)
    kd = apply_rope(rms_norm(kd.reshape(B, S, DIFF_HEADS, 2, DIFF_QK), diff_k_g), cos_diff, sin_diff)
    vd = vd.reshape(B, S, DIFF_HEADS, DIFF_V)
    lam_init = 0.8 - 0.6 * math.exp(-0.3 * layer_idx)
    f32 = jnp.float32
    lam = (jnp.exp(jnp.sum(lam_q1.astype(f32) * lam_k1.astype(f32)))
           - jnp.exp(jnp.sum(lam_q2.astype(f32) * lam_k2.astype(f32))) + lam_init)
    o_d = blocked_diff_attention(qd, kd, vd, lam, DIFF_QK ** -0.5)
    o_d = (rms_norm(o_d, subln_g) * (1.0 - lam_init)).reshape(B, S, DIFF_WIDTH)

    y = jnp.concatenate([o_mla * jax.nn.silu(g_mla),
                         o_na * jax.nn.silu(g_na),
                         o_d * jax.nn.silu(g_diff)], axis=-1) @ w_out
    return x + gate[:, None, :] * y


def setup_inputs(seed: int = 0) -> dict:
    key = jax.random.key(seed)
    ks = jax.random.split(key, 24)
    f32 = jnp.float32
    L = DEPTH

    def nrm(k, shape, s):
        return jax.random.normal(k, shape, f32) * s

    def gain(k, shape):
        return 1.0 + 0.05 * jax.random.normal(k, shape, f32)

    return {
        "x": jax.random.normal(ks[0], (BATCH, SEQ, D_MODEL), f32),
        "c": jax.random.normal(ks[1], (BATCH, D_MODEL), f32),
        "ada_w": nrm(ks[2], (L, D_MODEL, 3 * D_MODEL), 0.5 * D_MODEL ** -0.5),
        "ada_b": nrm(ks[3], (L, 3 * D_MODEL), 0.02),
        "norm_g": gain(ks[4], (L, D_MODEL)),
        "w_in": nrm(ks[5], (L, D_MODEL, N_IN), D_MODEL ** -0.5),
        "q_lat_g": gain(ks[6], (L, Q_LORA)),
        "w_uq": nrm(ks[7], (L, Q_LORA, MLA_HEADS * MLA_QK), Q_LORA ** -0.5),
        "kv_lat_g": gain(ks[8], (L, KV_LORA)),
        "w_ukv": nrm(ks[9], (L, KV_LORA, MLA_HEADS * (MLA_NOPE + MLA_V)), KV_LORA ** -0.5),
        "mla_q_g": gain(ks[10], (L, MLA_QK)),
        "mla_k_g": gain(ks[11], (L, MLA_QK)),
        "na_q_g": gain(ks[12], (L, NA_DIM)),
        "na_k_g": gain(ks[13], (L, NA_DIM)),
        "na_rpb": nrm(ks[14], (L, NA_HEADS, 2 * NA_KR_MAX - 1, 2 * NA_KC - 1), 0.1),
        "diff_q_g": gain(ks[15], (L, DIFF_QK)),
        "diff_k_g": gain(ks[16], (L, DIFF_QK)),
        "lam_q1": nrm(ks[17], (L, DIFF_QK), 0.1),
        "lam_k1": nrm(ks[18], (L, DIFF_QK), 0.1),
        "lam_q2": nrm(ks[19], (L, DIFF_QK), 0.1),
        "lam_k2": nrm(ks[20], (L, DIFF_QK), 0.1),
        "subln_g": gain(ks[21], (L, DIFF_V)),
        "w_out": nrm(ks[22], (L, MIX_WIDTH, D_MODEL), MIX_WIDTH ** -0.5),
    }


def reference(x, c, ada_w, ada_b, norm_g, w_in, q_lat_g, w_uq, kv_lat_g, w_ukv,
              mla_q_g, mla_k_g, na_q_g, na_k_g, na_rpb, diff_q_g, diff_k_g,
              lam_q1, lam_k1, lam_q2, lam_k2, subln_g, w_out):
    S = x.shape[1]
    cos_mla, sin_mla = rope_tables(S, MLA_ROPE)
    cos_diff, sin_diff = rope_tables(S, DIFF_QK)
    h = x
    for i in range(DEPTH):
        h = hybrid_layer(h, c, i, ada_w[i], ada_b[i], norm_g[i], w_in[i], q_lat_g[i], w_uq[i],
                         kv_lat_g[i], w_ukv[i], mla_q_g[i], mla_k_g[i], na_q_g[i], na_k_g[i],
                         na_rpb[i], diff_q_g[i], diff_k_g[i], lam_q1[i], lam_k1[i], lam_q2[i],
                         lam_k2[i], subln_g[i], w_out[i], cos_mla, sin_mla, cos_diff, sin_diff)
    return h
```

```cpp
#include <hip/hip_runtime.h>
#include <hip/hip_cooperative_groups.h>
#include <cstdio>
namespace cg = cooperative_groups;

typedef unsigned short u16;
using bf16x8 = __attribute__((ext_vector_type(8))) short;
using f32x16 = __attribute__((ext_vector_type(16))) float;
using u32x4  = __attribute__((ext_vector_type(4))) unsigned;
using u32x2  = __attribute__((ext_vector_type(2))) unsigned;

#define USE_COOP 1
#define REPS 1, 1, 1, 1, 1, 1

constexpr int D = 1024, NB = 8, S = 4096, M = NB * S, NL = 2;
constexpr int NIN = 3360, NINP = 3456, NP = 2336;
constexpr int NPS = 2368;
constexpr float EPS = 1e-6f;
constexpr float LOG2E = 1.4426950408889634f;

constexpr int C_CQ = 0, C_CKV = 256, C_KPE = 384, C_NAQ = 416, C_NAK = 800, C_NAV = 1184, C_DQ = 1568, C_DK = 1824, C_DV = 2080;

constexpr int XCD_BAR_WORDS_C = 3456;
constexpr size_t OFF_WIN  = 0;
constexpr size_t SZ_WIN   = (size_t)NL * NINP * 1024 * 2;
constexpr size_t OFF_WUQ  = OFF_WIN + SZ_WIN;
constexpr size_t SZ_WUQ   = (size_t)NL * 640 * 256 * 2;
constexpr size_t OFF_WUKV = OFF_WUQ + SZ_WUQ;
constexpr size_t SZ_WUKV  = (size_t)NL * 768 * 128 * 2;
constexpr size_t OFF_WOUT = OFF_WUKV + SZ_WUKV;
constexpr size_t SZ_WOUT  = (size_t)NL * 1024 * 1024 * 2;
constexpr size_t OFF_MOD  = OFF_WOUT + SZ_WOUT;
constexpr size_t SZ_MOD   = (size_t)NL * NB * 3072 * 4;
constexpr size_t OFF_LAM  = OFF_MOD + SZ_MOD;
constexpr size_t SZ_LAM   = 256;
constexpr size_t OFF_ROPE = OFF_LAM + SZ_LAM;
constexpr size_t SZ_ROPE  = (size_t)S * 16 * 8;
constexpr size_t OFF_A    = OFF_ROPE + SZ_ROPE;
constexpr size_t SZ_QRAW  = (size_t)M * 576 * 2;
constexpr size_t SZ_KVRAW = (size_t)M * 768 * 2;
constexpr size_t SZ_A     = SZ_QRAW + SZ_KVRAW;
constexpr size_t OFF_PROJ = OFF_A + SZ_A;
constexpr size_t SZ_PROJ  = (size_t)M * NPS * 2;
constexpr size_t OFF_KMLA = OFF_PROJ + SZ_PROJ;
constexpr size_t SZ_KMLA  = (size_t)NB * 6 * S * 96 * 2;
constexpr size_t OFF_VMLA = OFF_KMLA + SZ_KMLA;
constexpr size_t SZ_VMLA  = (size_t)NB * 6 * 64 * S * 2;
constexpr size_t OFF_VNA  = OFF_VMLA + SZ_VMLA;
constexpr size_t SZ_VNA   = SZ_VMLA;
constexpr size_t OFF_VD   = OFF_VNA + SZ_VNA;
constexpr size_t SZ_VD    = (size_t)NB * 4 * 64 * S * 2;
constexpr size_t OFF_MIX  = OFF_VD + SZ_VD;
constexpr size_t SZ_MIX   = (size_t)M * 1024 * 2;
constexpr size_t OFF_BAR  = OFF_MIX + SZ_MIX;
constexpr size_t SZ_BAR   = (size_t)XCD_BAR_WORDS_C * 4;
constexpr size_t WS_TOTAL = OFF_BAR + SZ_BAR;
static_assert(WS_TOTAL <= (size_t)512 * 1024 * 1024, "workspace too large");

constexpr int SMEM_BYTES = 110592;
constexpr int NT = 512;

struct Params {
  const float *x, *c, *ada_w, *ada_b, *norm_g, *w_in, *q_lat_g, *w_uq, *kv_lat_g, *w_ukv, *mla_q_g, *mla_k_g,
      *na_q_g, *na_k_g, *na_rpb, *diff_q_g, *diff_k_g, *lam_q1, *lam_k1, *lam_q2, *lam_k2, *subln_g, *w_out;
  float* out;
  char* ws;
  int phase_lo, phase_hi;
  int reps[6];
};

typedef __bf16 bf16x2_t __attribute__((ext_vector_type(2)));
typedef float f32x2_t __attribute__((ext_vector_type(2)));
__device__ __forceinline__ unsigned cvtpk(float lo, float hi) {
  f32x2_t f = {lo, hi};
  bf16x2_t b = __builtin_convertvector(f, bf16x2_t);
  return __builtin_bit_cast(unsigned, b);
}
__device__ __forceinline__ float bflo(unsigned w) { return __uint_as_float(w << 16); }
__device__ __forceinline__ float bfhi(unsigned w) { return __uint_as_float(w & 0xffff0000u); }
__device__ __forceinline__ float silu_f(float v) { return v / (1.f + __expf(-v)); }
__device__ __forceinline__ f32x16 mfma(bf16x8 a, bf16x8 b, f32x16 c) { return __builtin_amdgcn_mfma_f32_32x32x16_bf16(a, b, c, 0, 0, 0); }
__device__ __forceinline__ int crow(int reg, int h) { return (reg & 3) + 8 * (reg >> 2) + 4 * h; }

__device__ __forceinline__ void transpose_tile(const float* __restrict__ src, int K, int N, const float* __restrict__ gain,
                               u16* __restrict__ dst, int kt, int nt, float* lds) {
  const int tid = threadIdx.x;
  for (int i = tid; i < 4096; i += NT) {
    int kk = i >> 6, nn = i & 63;
    int k = kt * 64 + kk, n = nt * 64 + nn;
    float v = (n < N) ? src[(size_t)k * N + n] : 0.f;
    if (gain) v *= gain[k];
    lds[kk * 65 + nn] = v;
  }
  __syncthreads();
  for (int i = tid; i < 512; i += NT) {
    int nn = i >> 3, kc = i & 7;
    float f[8];
#pragma unroll
    for (int j = 0; j < 8; ++j) f[j] = lds[(kc * 8 + j) * 65 + nn];
    u32x4 w = {cvtpk(f[0], f[1]), cvtpk(f[2], f[3]), cvtpk(f[4], f[5]), cvtpk(f[6], f[7])};
    *(u32x4*)&dst[(size_t)(nt * 64 + nn) * K + kt * 64 + kc * 8] = w;
  }
  __syncthreads();
}

__device__ __forceinline__ void mod_item(const Params& p, int item, char* smem) {
  const int l = item / 48, jt = item % 48;
  const int tid = threadIdx.x, jj = tid & 63, kq = tid >> 6;
  float* sc = (float*)smem;
  float* part = sc + 8192;
  for (int i = tid; i < 8192; i += NT) sc[i] = silu_f(p.c[i]);
  __syncthreads();
  float acc[8];
#pragma unroll
  for (int b = 0; b < 8; ++b) acc[b] = 0.f;
  const float* w = p.ada_w + (size_t)l * 1024 * 3072 + jt * 64 + jj;
#pragma unroll 4
  for (int k = kq * 128; k < kq * 128 + 128; ++k) {
    float wv = w[(size_t)k * 3072];
#pragma unroll
    for (int b = 0; b < 8; ++b) acc[b] += sc[b * 1024 + k] * wv;
  }
#pragma unroll
  for (int b = 0; b < 8; ++b) part[(kq * 8 + b) * 64 + jj] = acc[b];
  __syncthreads();
  float* mod = (float*)(p.ws + OFF_MOD);
  for (int i = tid; i < 512; i += NT) {
    int b = i >> 6, j = i & 63;
    float v = 0.f;
#pragma unroll
    for (int q = 0; q < 8; ++q) v += part[(q * 8 + b) * 64 + j];
    v += p.ada_b[l * 3072 + jt * 64 + j];
    mod[((size_t)l * NB + b) * 3072 + jt * 64 + j] = v;
  }
  __syncthreads();
}

__device__ __forceinline__ void rope_item(const Params& p, int item) {
  const int e = item * NT + threadIdx.x;
  const int s = e >> 4, i = e & 15;
  double inv = 1.0;
  for (int j = 0; j < i; ++j) inv *= 0.5623413251903491;
  double rev = (double)s * inv * 0.15915494309189535;
  double fr = rev - floor(rev);
  float f = (float)fr;
  float2 cs;
  cs.x = __builtin_amdgcn_cosf(f);
  cs.y = __builtin_amdgcn_sinf(f);
  ((float2*)(p.ws + OFF_ROPE))[e] = cs;
}

__device__ __forceinline__ void phase_prep(const Params& p, char* smem) {
  constexpr int T_PER_L = 864 + 40 + 24 + 256;
  for (int item = blockIdx.x; item < 2593; item += gridDim.x) {
    if (item < 2 * T_PER_L) {
      int l = item / T_PER_L, t = item % T_PER_L;
      if (t < 864) {
        int kt = t / 54, nt = t % 54;
        transpose_tile(p.w_in + (size_t)l * 1024 * NIN, 1024, NIN, nullptr,
                       (u16*)(p.ws + OFF_WIN) + (size_t)l * NINP * 1024, kt, nt, (float*)smem);
      } else if (t < 904) {
        t -= 864; int kt = t / 10, nt = t % 10;
        transpose_tile(p.w_uq + (size_t)l * 256 * 576, 256, 576, p.q_lat_g + l * 256,
                       (u16*)(p.ws + OFF_WUQ) + (size_t)l * 640 * 256, kt, nt, (float*)smem);
      } else if (t < 928) {
        t -= 904; int kt = t / 12, nt = t % 12;
        transpose_tile(p.w_ukv + (size_t)l * 128 * 768, 128, 768, p.kv_lat_g + l * 128,
                       (u16*)(p.ws + OFF_WUKV) + (size_t)l * 768 * 128, kt, nt, (float*)smem);
      } else {
        t -= 928; int kt = t / 16, nt = t % 16;
        transpose_tile(p.w_out + (size_t)l * 1024 * 1024, 1024, 1024, nullptr,
                       (u16*)(p.ws + OFF_WOUT) + (size_t)l * 1024 * 1024, kt, nt, (float*)smem);
      }
    } else if (item < 2464) {
      mod_item(p, item - 2368, smem);
    } else if (item < 2592) {
      rope_item(p, item - 2464);
    } else {
      if (threadIdx.x < NL) {
        int l = threadIdx.x;
        float s1 = 0.f, s2 = 0.f;
        for (int i = 0; i < 32; ++i) {
          s1 += p.lam_q1[l * 32 + i] * p.lam_k1[l * 32 + i];
          s2 += p.lam_q2[l * 32 + i] * p.lam_k2[l * 32 + i];
        }
        float lam_init = 0.8f - 0.6f * expf(-0.3f * (float)l);
        ((float*)(p.ws + OFF_LAM))[l] = expf(s1) - expf(s2) + lam_init;
      }
    }
  }
}

__device__ __forceinline__ void phase_norm(const Params& p, int l) {
  const float* xin = (l == 0) ? p.x : p.out;
  const float* g = p.norm_g + l * 1024;
  const float* mod = (const float*)(p.ws + OFF_MOD) + (size_t)l * NB * 3072;
  u16* hbuf = (u16*)(p.ws + OFF_A);
  const int lane = threadIdx.x & 63, wave = threadIdx.x >> 6;
  for (int item = blockIdx.x; item < M / 8; item += gridDim.x) {
    const int row = item * 8 + wave;
    const int b = row / S;
    const float* xr = xin + (size_t)row * 1024;
    float v[16];
#pragma unroll
    for (int hf = 0; hf < 2; ++hf) {
      float4 a = *(const float4*)(xr + hf * 512 + lane * 8);
      float4 c = *(const float4*)(xr + hf * 512 + lane * 8 + 4);
      v[hf * 8 + 0] = a.x; v[hf * 8 + 1] = a.y; v[hf * 8 + 2] = a.z; v[hf * 8 + 3] = a.w;
      v[hf * 8 + 4] = c.x; v[hf * 8 + 5] = c.y; v[hf * 8 + 6] = c.z; v[hf * 8 + 7] = c.w;
    }
    float ss = 0.f;
#pragma unroll
    for (int i = 0; i < 16; ++i) ss += v[i] * v[i];
#pragma unroll
    for (int o = 32; o >= 1; o >>= 1) ss += __shfl_xor(ss, o);
    const float rstd = rsqrtf(ss * (1.f / 1024.f) + EPS);
    const float* shift = mod + (size_t)b * 3072;
    const float* scale = shift + 1024;
#pragma unroll
    for (int hf = 0; hf < 2; ++hf) {
      const int c0 = hf * 512 + lane * 8;
      float o[8];
#pragma unroll
      for (int j = 0; j < 8; ++j) o[j] = v[hf * 8 + j] * rstd * g[c0 + j] * (1.f + scale[c0 + j]) + shift[c0 + j];
      u32x4 w = {cvtpk(o[0], o[1]), cvtpk(o[2], o[3]), cvtpk(o[4], o[5]), cvtpk(o[6], o[7])};
      *(u32x4*)&hbuf[(size_t)row * 1024 + c0] = w;
    }
  }
}

template <bool STAGED, int NK, class Tr, class Dst, class Epi>
__device__ __forceinline__ void gemm_tile(const u16* __restrict__ A, int lda, const u16* __restrict__ Bt, int ldb,
                                          int m0, int n0, char* smem, Tr tr, Dst dstf, Epi epi) {
  constexpr int LDT = 72;
  constexpr int STAGE = (256 + 128) * LDT;
  u16* As = (u16*)smem;
  u16* Bs = As + 256 * LDT;
  const int tid = threadIdx.x, lane = tid & 63, wave = tid >> 6;
  const int wm = wave >> 1, wn = wave & 1;
  const int r = lane & 31, h = lane >> 5;
  f32x16 acc[2][2];
#pragma unroll
  for (int i = 0; i < 2; ++i)
#pragma unroll
    for (int j = 0; j < 2; ++j)
#pragma unroll
      for (int q = 0; q < 16; ++q) acc[i][j][q] = 0.f;
  constexpr int nk = NK;
  u32x4 ra0[4], rb0[2], ra1[4], rb1[2];
  const int lrow = tid >> 3, lkc = tid & 7;
  const u16* Ap = A + (size_t)(m0 + lrow) * lda + lkc * 8;
  const u16* Bp = Bt + (size_t)(n0 + lrow) * ldb + lkc * 8;
#define GLOAD(RA, RB, kt) { _Pragma("unroll") for (int i = 0; i < 4; ++i) RA[i] = *(const u32x4*)(Ap + (size_t)(i * 64) * lda + (kt) * 64); \
                            _Pragma("unroll") for (int i = 0; i < 2; ++i) RB[i] = *(const u32x4*)(Bp + (size_t)(i * 64) * ldb + (kt) * 64); }
#define SSTORE(RA, RB, buf) { _Pragma("unroll") for (int i = 0; i < 4; ++i) *(u32x4*)&As[(buf) * STAGE + (lrow + i * 64) * LDT + lkc * 8] = RA[i]; \
                              _Pragma("unroll") for (int i = 0; i < 2; ++i) *(u32x4*)&Bs[(buf) * STAGE + (lrow + i * 64) * LDT + lkc * 8] = RB[i]; }
  auto compute = [&](int buf) {
    const u16* as = As + buf * STAGE + (wm * 64 + r) * LDT + h * 8;
    const u16* bs = Bs + buf * STAGE + (wn * 64 + r) * LDT + h * 8;
#pragma unroll
    for (int ks = 0; ks < 4; ++ks) {
      bf16x8 a0 = *(const bf16x8*)(as + ks * 16);
      bf16x8 a1 = *(const bf16x8*)(as + 32 * LDT + ks * 16);
      bf16x8 b0 = *(const bf16x8*)(bs + ks * 16);
      bf16x8 b1 = *(const bf16x8*)(bs + 32 * LDT + ks * 16);
      acc[0][0] = mfma(a0, b0, acc[0][0]);
      acc[0][1] = mfma(a0, b1, acc[0][1]);
      acc[1][0] = mfma(a1, b0, acc[1][0]);
      acc[1][1] = mfma(a1, b1, acc[1][1]);
    }
  };
  GLOAD(ra0, rb0, 0);
  SSTORE(ra0, rb0, 0);
  GLOAD(ra1, rb1, 1);
  __syncthreads();
#pragma unroll
  for (int kt = 0; kt < nk; kt += 2) {
    if (kt + 2 < nk) GLOAD(ra0, rb0, kt + 2);
    compute(0);
    SSTORE(ra1, rb1, 1);
    __syncthreads();
    if (kt + 3 < nk) GLOAD(ra1, rb1, kt + 3);
    compute(1);
    if (kt + 2 < nk) SSTORE(ra0, rb0, 0);
    __syncthreads();
  }
#undef GLOAD
#undef SSTORE
  if (STAGED) {
    u16* Cw = (u16*)smem + wave * (64 * 72);
    const bool odd = lane & 1;
#pragma unroll
    for (int mb = 0; mb < 2; ++mb)
#pragma unroll
      for (int nb = 0; nb < 2; ++nb) {
        const int cl = nb * 32 + r;
        const int gcol = n0 + wn * 64 + cl;
#pragma unroll
        for (int q = 0; q < 16; q += 2) {
          const float a = tr(gcol, acc[mb][nb][q]), b = tr(gcol, acc[mb][nb][q + 1]);
          const float x = odd ? a : b;
          const float y = __int_as_float(__builtin_amdgcn_update_dpp(0, __float_as_int(x), 0xB1, 0xF, 0xF, true));
          const unsigned pk = odd ? cvtpk(y, b) : cvtpk(a, y);
          const int rl = mb * 32 + crow(q, h) + (odd ? 1 : 0);
          *(unsigned*)&Cw[rl * 72 + (cl & ~1)] = pk;
        }
      }
    __syncthreads();
#pragma unroll
    for (int i = 0; i < 8; ++i) {
      const int id = lane + i * 64;
      const int row = id >> 3, ch = id & 7;
      u32x4 v = *(const u32x4*)&Cw[row * 72 + ch * 8];
      u16* d = dstf(m0 + wm * 64 + row, n0 + wn * 64 + ch * 8);
      if (d) *(u32x4*)d = v;
    }
    __syncthreads();
  } else {
#pragma unroll
    for (int mb = 0; mb < 2; ++mb)
#pragma unroll
      for (int nb = 0; nb < 2; ++nb) {
        const int col = n0 + wn * 64 + nb * 32 + r;
#pragma unroll
        for (int q = 0; q < 16; ++q) {
          const int row = m0 + wm * 64 + mb * 32 + crow(q, h);
          epi(row, col, acc[mb][nb][q]);
        }
      }
  }
}

__shared__ int s_vb;
__device__ __forceinline__ int vblock() { return s_vb; }

__device__ __forceinline__ void phase_gemm1(const Params& p, int l, char* smem) {
  const u16* A = (const u16*)(p.ws + OFF_A);
  const u16* Bt = (const u16*)(p.ws + OFF_WIN) + (size_t)l * NINP * 1024;
  u16* proj = (u16*)(p.ws + OFF_PROJ);
  u16* mix = (u16*)(p.ws + OFF_MIX);
  for (int t = vblock(); t < 128 * 27; t += gridDim.x) {
    const int mt = t / 27, nt = t % 27;
    gemm_tile<true, 16>(A, 1024, Bt, 1024, mt * 256, nt * 128, smem,
      [&](int col, float v) { return (col >= NP) ? silu_f(v) : v; },
      [&](int row, int col8) -> u16* { return (col8 < NP) ? proj + (size_t)row * NPS + col8 : ((col8 < NIN) ? mix + (size_t)row * 1024 + (col8 - NP) : (u16*)nullptr); },
      [&](int, int, float) {});
  }
}

__device__ __forceinline__ void phase_upproj(const Params& p, int l, char* smem) {
  const u16* proj = (const u16*)(p.ws + OFF_PROJ);
  u16* qraw = (u16*)(p.ws + OFF_A);
  u16* kvraw = (u16*)(p.ws + OFF_A + SZ_QRAW);
  const u16* wuq = (const u16*)(p.ws + OFF_WUQ) + (size_t)l * 640 * 256;
  const u16* wukv = (const u16*)(p.ws + OFF_WUKV) + (size_t)l * 768 * 128;
  for (int t = vblock(); t < 128 * 11; t += gridDim.x) {
    const int mt = t / 11, nt = t % 11;
    if (nt < 5) {
      gemm_tile<true, 4>(proj + C_CQ, NPS, wuq, 256, mt * 256, nt * 128, smem,
        [&](int, float v) { return v; },
        [&](int row, int col8) -> u16* { return (col8 < 576) ? qraw + (size_t)row * 576 + col8 : (u16*)nullptr; },
        [&](int, int, float) {});
    } else {
      gemm_tile<true, 2>(proj + C_CKV, NPS, wukv, 128, mt * 256, (nt - 5) * 128, smem,
        [&](int, float v) { return v; },
        [&](int row, int col8) -> u16* { return kvraw + (size_t)row * 768 + col8; },
        [&](int, int, float) {});
    }
  }
}

__device__ __forceinline__ void phase_gemm2(const Params& p, int l, char* smem, bool dry) {
  const u16* A = (const u16*)(p.ws + OFF_MIX);
  const u16* Bt = (const u16*)(p.ws + OFF_WOUT) + (size_t)l * 1024 * 1024;
  const float* xin = (l == 0) ? p.x : p.out;
  const float* gate = (const float*)(p.ws + OFF_MOD) + (size_t)l * NB * 3072 + 2048;
  float* out = p.out;
  for (int t = vblock(); t < 128 * 8; t += gridDim.x) {
    const int mt = t / 8, nt = t % 8;
    const int b = (mt * 256) / S;
    const float* gb = gate + (size_t)b * 3072;
    gemm_tile<false, 16>(A, 1024, Bt, 1024, mt * 256, nt * 128, smem,
      [&](int, float v) { return v; }, [&](int, int) -> u16* { return nullptr; },
      [&](int row, int col, float v) {
        const size_t idx = (size_t)row * 1024 + col;
        float o = xin[idx] + gb[col] * v;
        if (!dry) out[idx] = o;
      });
  }
}

template <int N8>
__device__ __forceinline__ void ld_bf16(const u16* __restrict__ ptr, float* v, float sc) {
#pragma unroll
  for (int c = 0; c < N8; ++c) {
    u32x4 w = *(const u32x4*)(ptr + c * 8);
#pragma unroll
    for (int j = 0; j < 4; ++j) { v[c * 8 + 2 * j] = bflo(w[j]) * sc; v[c * 8 + 2 * j + 1] = bfhi(w[j]) * sc; }
  }
}
template <int N8>
__device__ __forceinline__ void st_bf16v(u16* __restrict__ ptr, const float* v) {
#pragma unroll
  for (int c = 0; c < N8; ++c) {
    u32x4 w = {cvtpk(v[c * 8 + 0], v[c * 8 + 1]), cvtpk(v[c * 8 + 2], v[c * 8 + 3]), cvtpk(v[c * 8 + 4], v[c * 8 + 5]), cvtpk(v[c * 8 + 6], v[c * 8 + 7])};
    *(u32x4*)(ptr + c * 8) = w;
  }
}
typedef const float __attribute__((address_space(4))) * cfptr;
template <int N8, bool ROPE>
__device__ __forceinline__ void unit_proc(u32x4* w, float sc0, float sc1, const float* __restrict__ g_, const float2* __restrict__ cs, float outscale) {
  cfptr g = (cfptr)g_;
  constexpr int DD = N8 * 8;
  constexpr int NR = ROPE ? N8 - 4 : N8;
  float ss = 0.f;
#pragma unroll
  for (int c = 0; c < N8; ++c) {
    const float sc = (c < NR) ? sc0 : sc1;
#pragma unroll
    for (int j = 0; j < 4; ++j) { float a = bflo(w[c][j]) * sc, b = bfhi(w[c][j]) * sc; ss += a * a + b * b; }
  }
  const float rr = rsqrtf(ss * (1.f / DD) + EPS);
#pragma unroll
  for (int c = 0; c < NR; ++c) {
    const float sc = sc0 * rr;
#pragma unroll
    for (int j = 0; j < 4; ++j) {
      float a = bflo(w[c][j]) * sc * g[c * 8 + 2 * j] * outscale, b = bfhi(w[c][j]) * sc * g[c * 8 + 2 * j + 1] * outscale;
      w[c][j] = cvtpk(a, b);
    }
  }
  if (ROPE) {
    float v[32];
    const float sc = sc1 * rr;
#pragma unroll
    for (int c = 0; c < 4; ++c)
#pragma unroll
      for (int j = 0; j < 4; ++j) {
        v[c * 8 + 2 * j] = bflo(w[NR + c][j]) * sc * g[(NR + c) * 8 + 2 * j];
        v[c * 8 + 2 * j + 1] = bfhi(w[NR + c][j]) * sc * g[(NR + c) * 8 + 2 * j + 1];
      }
#pragma unroll
    for (int i = 0; i < 16; ++i) {
      float2 c = cs[i];
      float x1 = v[i], x2 = v[16 + i];
      v[i] = (x1 * c.x - x2 * c.y) * outscale;
      v[16 + i] = (x2 * c.x + x1 * c.y) * outscale;
    }
#pragma unroll
    for (int c = 0; c < 4; ++c)
#pragma unroll
      for (int j = 0; j < 4; ++j) w[NR + c][j] = cvtpk(v[c * 8 + 2 * j], v[c * 8 + 2 * j + 1]);
  }
}
template <int N8>
__device__ __forceinline__ void ldw(const u16* __restrict__ ptr, u32x4* w) {
#pragma unroll
  for (int c = 0; c < N8; ++c) w[c] = *(const u32x4*)(ptr + c * 8);
}
template <int N8>
__device__ __forceinline__ void stw(u16* __restrict__ ptr, const u32x4* w, bool dry) {
  if (dry) return;
#pragma unroll
  for (int c = 0; c < N8; ++c) *(u32x4*)(ptr + c * 8) = w[c];
}

__device__ __forceinline__ void phase_post(const Params& p, int l, char* smem, bool dry) {
  u16* proj = (u16*)(p.ws + OFF_PROJ);
  u16* qraw = (u16*)(p.ws + OFF_A);
  const u16* kvraw = (const u16*)(p.ws + OFF_A + SZ_QRAW);
  u16* kmla = (u16*)(p.ws + OFF_KMLA);
  const float2* rope = (const float2*)(p.ws + OFF_ROPE);
  float* rstd_q = (float*)smem;
  float* rstd_kv = rstd_q + 64;
  u16* tbuf = (u16*)(smem + 512);
  const int tid = threadIdx.x, lane = tid & 63, wave = tid >> 6;
  for (int item = blockIdx.x; item < M / 64; item += gridDim.x) {
    const int t0 = item * 64;
    const int b = t0 / S, s0 = t0 % S;
    {
      const int tok = tid >> 3, part = tid & 7;
      const u16* pr = proj + (size_t)(t0 + tok) * NPS;
      float v[32];
      ld_bf16<4>(pr + C_CQ + part * 32, v, 1.f);
      float sq = 0.f;
#pragma unroll
      for (int i = 0; i < 32; ++i) sq += v[i] * v[i];
      ld_bf16<2>(pr + C_CKV + part * 16, v, 1.f);
      float skv = 0.f;
#pragma unroll
      for (int i = 0; i < 16; ++i) skv += v[i] * v[i];
      sq += __shfl_xor(sq, 1); sq += __shfl_xor(sq, 2); sq += __shfl_xor(sq, 4);
      skv += __shfl_xor(skv, 1); skv += __shfl_xor(skv, 2); skv += __shfl_xor(skv, 4);
      if (part == 0) {
        rstd_q[tok] = rsqrtf(sq * (1.f / 256.f) + EPS);
        rstd_kv[tok] = rsqrtf(skv * (1.f / 128.f) + EPS);
      }
    }
    __syncthreads();
    {
      const int tok = lane;
      const int t = t0 + tok;
      const float2* cs = rope + (size_t)(s0 + tok) * 16;
      u16* pr = proj + (size_t)t * NPS;
#pragma unroll 1
      for (int u = 0 + ((wave - 0) & 7); u < 6; u += 8) {
        u32x4 w[12];
        u16* ptr = qraw + (size_t)t * 576 + u * 96;
        ldw<12>(ptr, w);
        unit_proc<12, true>(w, rstd_q[tok], rstd_q[tok], p.mla_q_g + l * 96, cs, 0.10206207261596575f * LOG2E);
        stw<12>(ptr, w, dry);
      }
#pragma unroll 1
      for (int u = 6 + ((wave - 6) & 7); u < 12; u += 8) {
        const int hh = u - 6;
        u32x4 w[12];
        ldw<8>(kvraw + (size_t)t * 768 + hh * 128, w);
        ldw<4>(pr + C_KPE, w + 8);
        unit_proc<12, true>(w, rstd_kv[tok], 1.f, p.mla_k_g + l * 96, cs, 1.f);
        stw<12>(kmla + ((size_t)(b * 6 + hh) * S + s0 + tok) * 96, w, dry);
      }
#pragma unroll 1
      for (int u = 12 + ((wave - 12) & 7); u < 18; u += 8) {
        u32x4 w[8];
        u16* ptr = pr + C_NAQ + (u - 12) * 64;
        ldw<8>(ptr, w);
        unit_proc<8, false>(w, 1.f, 1.f, p.na_q_g + l * 64, cs, 0.125f * LOG2E);
        stw<8>(ptr, w, dry);
      }
#pragma unroll 1
      for (int u = 18 + ((wave - 18) & 7); u < 24; u += 8) {
        u32x4 w[8];
        u16* ptr = pr + C_NAK + (u - 18) * 64;
        ldw<8>(ptr, w);
        unit_proc<8, false>(w, 1.f, 1.f, p.na_k_g + l * 64, cs, 1.f);
        stw<8>(ptr, w, dry);
      }
#pragma unroll 1
      for (int u = 24 + ((wave - 24) & 7); u < 32; u += 8) {
        u32x4 w[4];
        u16* ptr = pr + C_DQ + (u - 24) * 32;
        ldw<4>(ptr, w);
        unit_proc<4, true>(w, 1.f, 1.f, p.diff_q_g + l * 32, cs, 0.17677669529663687f * LOG2E);
        stw<4>(ptr, w, dry);
      }
#pragma unroll 1
      for (int u = 32 + ((wave - 32) & 7); u < 40; u += 8) {
        u32x4 w[4];
        u16* ptr = pr + C_DK + (u - 32) * 32;
        ldw<4>(ptr, w);
        unit_proc<4, true>(w, 1.f, 1.f, p.diff_k_g + l * 32, cs, 1.f);
        stw<4>(ptr, w, dry);
      }
    }
    {
      u16* T = tbuf + wave * (64 * 72);
      const int plane = (lane & ~15) | ((lane & 3) | ((lane & 4) << 1) | ((lane & 8) >> 1));
#pragma unroll 1
      for (int mi = wave; mi < 16; mi += 8) {
        const u16* src; u16* dst; float sc = 1.f;
        const int t = t0 + lane;
        if (mi < 6) {
          src = kvraw + (size_t)t * 768 + mi * 128 + 64; sc = rstd_kv[lane];
          dst = (u16*)(p.ws + OFF_VMLA) + (size_t)(b * 6 + mi) * 64 * S + s0;
        } else if (mi < 12) {
          src = proj + (size_t)t * NPS + C_NAV + (mi - 6) * 64;
          dst = (u16*)(p.ws + OFF_VNA) + (size_t)(b * 6 + (mi - 6)) * 64 * S + s0;
        } else {
          src = proj + (size_t)t * NPS + C_DV + (mi - 12) * 64;
          dst = (u16*)(p.ws + OFF_VD) + (size_t)(b * 4 + (mi - 12)) * 64 * S + s0;
        }
#pragma unroll
        for (int c = 0; c < 8; ++c) {
          u32x4 w = *(const u32x4*)(src + c * 8);
#pragma unroll
          for (int j = 0; j < 4; ++j) {
            unsigned pk = cvtpk(bflo(w[j]) * sc, bfhi(w[j]) * sc);
            T[(c * 8 + 2 * j) * 72 + plane] = (u16)(pk & 0xffffu);
            T[(c * 8 + 2 * j + 1) * 72 + plane] = (u16)(pk >> 16);
          }
        }
        __syncthreads();
#pragma unroll
        for (int c = 0; c < 8; ++c) {
          u32x4 w = *(const u32x4*)&T[lane * 72 + c * 8];
          if (!dry) *(u32x4*)(dst + (size_t)lane * S + c * 8) = w;
        }
        __syncthreads();
      }
    }
    __syncthreads();
  }
}

constexpr int ATT_VS_OFF = 2 * 128 * 104 * 2;
constexpr int ATT_LDS_END = ATT_VS_OFF + 2 * 64 * 136 * 2;
template <int DQK, bool NA, int KT>
__device__ __forceinline__ void attn_pass(const u16* __restrict__ Qw, int ldq, const u16* __restrict__ Kg, int ldk,
                                          const u16* __restrict__ Vt, int ntiles, char* smem, f32x16 (&O)[2],
                                          float& lsum, int rq, int kr_lo, int cbase, const float* __restrict__ bias_lds) {
  constexpr int LDK = DQK + 8, LDV = KT + 8;
  constexpr int KCH = DQK / 8;
  constexpr int KPT = (KT * KCH + NT - 1) / NT;
  constexpr int VCH = KT / 8;
  constexpr int VPT = 64 * VCH / NT;
  constexpr int NKS = DQK / 16;
  u16* Ks = (u16*)smem;
  u16* Vs = (u16*)(smem + ATT_VS_OFF);
  const int tid = threadIdx.x, lane = tid & 63, r = lane & 31, h = lane >> 5;
  bf16x8 qf[NKS];
#pragma unroll
  for (int ks = 0; ks < NKS; ++ks) qf[ks] = *(const bf16x8*)&Qw[(size_t)r * ldq + ks * 16 + h * 8];
  u32x4 kreg[KPT], vreg[VPT];
  auto gload = [&](int t) {
#pragma unroll
    for (int i = 0; i < KPT; ++i) {
      const int c = tid + i * NT;
      if (c < KT * KCH) {
        const int row = c / KCH, col = c % KCH;
        kreg[i] = *(const u32x4*)&Kg[(size_t)(t * KT + row) * ldk + col * 8];
      }
    }
#pragma unroll
    for (int i = 0; i < VPT; ++i) {
      const int c = tid + i * NT;
      const int row = c / VCH, col = c % VCH;
      vreg[i] = *(const u32x4*)&Vt[(size_t)row * S + t * KT + col * 8];
    }
  };
  auto sstore = [&](int buf) {
#pragma unroll
    for (int i = 0; i < KPT; ++i) {
      const int c = tid + i * NT;
      if (c < KT * KCH) {
        const int row = c / KCH, col = c % KCH;
        *(u32x4*)&Ks[buf * KT * LDK + row * LDK + col * 8] = kreg[i];
      }
    }
#pragma unroll
    for (int i = 0; i < VPT; ++i) {
      const int c = tid + i * NT;
      const int row = c / VCH, col = c % VCH;
      *(u32x4*)&Vs[buf * 64 * LDV + row * LDV + col * 8] = vreg[i];
    }
  };
  auto compute = [&](int buf, int t) {
    const u16* ks_ = Ks + buf * KT * LDK + r * LDK + h * 8;
    const u16* vs_ = Vs + buf * 64 * LDV + r * LDV + h * 8;
    auto step = [&](int kb, bf16x8 (&kcur)[NKS], bf16x8 (&knext)[NKS], bool pre) {
      bf16x8 vfr[4];
#pragma unroll
      for (int db = 0; db < 2; ++db)
#pragma unroll
        for (int sx = 0; sx < 2; ++sx) vfr[db * 2 + sx] = *(const bf16x8*)(vs_ + db * 32 * LDV + (kb * 2 + sx) * 16);
      if (pre) {
#pragma unroll
        for (int ks = 0; ks < NKS; ++ks) knext[ks] = *(const bf16x8*)(ks_ + (kb + 1) * 32 * LDK + ks * 16);
      }
      f32x16 s;
#pragma unroll
      for (int q = 0; q < 16; ++q) s[q] = 0.f;
#pragma unroll
      for (int ks = 0; ks < NKS; ++ks) s = mfma(kcur[ks], qf[ks], s);
      float pv[16];
      if (NA) {
        const int c = cbase + r;
        const int c0 = min(max(c - 8, 0), 48);
        const int dr = (kr_lo + t) - rq + 7;
#pragma unroll
        for (int q = 0; q < 16; ++q) {
          const int kc = kb * 32 + crow(q, h);
          const bool valid = (unsigned)(kc - c0) < 16u;
          const int bi = valid ? (dr * 31 + kc - c + 15) : 0;
          const float e = __builtin_amdgcn_exp2f(s[q] + bias_lds[bi]);
          pv[q] = valid ? e : 0.f;
        }
      } else {
#pragma unroll
        for (int q = 0; q < 16; ++q) pv[q] = __builtin_amdgcn_exp2f(s[q]);
      }
      lsum += ((pv[0] + pv[1]) + (pv[2] + pv[3])) + ((pv[4] + pv[5]) + (pv[6] + pv[7])) +
              (((pv[8] + pv[9]) + (pv[10] + pv[11])) + ((pv[12] + pv[13]) + (pv[14] + pv[15])));
      bf16x8 pf[2];
#pragma unroll
      for (int sx = 0; sx < 2; ++sx) {
        u32x4 w = {cvtpk(pv[sx * 8 + 0], pv[sx * 8 + 1]), cvtpk(pv[sx * 8 + 2], pv[sx * 8 + 3]),
                   cvtpk(pv[sx * 8 + 4], pv[sx * 8 + 5]), cvtpk(pv[sx * 8 + 6], pv[sx * 8 + 7])};
        pf[sx] = __builtin_bit_cast(bf16x8, w);
      }
#pragma unroll
      for (int db = 0; db < 2; ++db)
#pragma unroll
        for (int sx = 0; sx < 2; ++sx) {
          O[db] = mfma(vfr[db * 2 + sx], pf[sx], O[db]);
        }
    };
    bf16x8 kfa[NKS], kfb[NKS];
#pragma unroll
    for (int ks = 0; ks < NKS; ++ks) kfa[ks] = *(const bf16x8*)(ks_ + ks * 16);
#pragma unroll 1
    for (int kb = 0; kb < KT / 32; kb += 2) {
      step(kb, kfa, kfb, true);
      step(kb + 1, kfb, kfa, kb + 2 < KT / 32);
    }
  };
  gload(0); sstore(0);
  __syncthreads();
#pragma unroll 1
  for (int t = 0; t < ntiles; ++t) {
    if (t + 1 < ntiles) gload(t + 1);
    bool act = true;
    if (NA) { const int r0 = min(max(rq - 4, 0), 56); const int kr = kr_lo + t; act = (kr >= r0) && (kr < r0 + 8); }
    if (act) compute(t & 1, t);
    if (t + 1 < ntiles) sstore((t + 1) & 1);
    __syncthreads();
  }
}

template <int KT>
__device__ __forceinline__ void diff_pass(const u16* __restrict__ Qw, int ldq, const u16* __restrict__ Kg, int ldk,
                                          const u16* __restrict__ Vt, int ntiles, char* smem, f32x16 (&O0)[2], f32x16 (&O1)[2],
                                          float& l0, float& l1) {
  constexpr int LDK = 72, LDV = KT + 8;
  constexpr int KPT = KT * 8 / NT;
  constexpr int VCH = KT / 8;
  constexpr int VPT = 64 * VCH / NT;
  u16* Ks = (u16*)smem;
  u16* Vs = (u16*)(smem + ATT_VS_OFF);
  const int tid = threadIdx.x, lane = tid & 63, r = lane & 31, h = lane >> 5;
  bf16x8 qf[4];
#pragma unroll
  for (int ks = 0; ks < 4; ++ks) qf[ks] = *(const bf16x8*)&Qw[(size_t)r * ldq + ks * 16 + h * 8];
  u32x4 kreg[KPT], vreg[VPT];
  auto gload = [&](int t) {
#pragma unroll
    for (int i = 0; i < KPT; ++i) { const int c = tid + i * NT; kreg[i] = *(const u32x4*)&Kg[(size_t)(t * KT + (c >> 3)) * ldk + (c & 7) * 8]; }
#pragma unroll
    for (int i = 0; i < VPT; ++i) { const int c = tid + i * NT; vreg[i] = *(const u32x4*)&Vt[(size_t)(c / VCH) * S + t * KT + (c % VCH) * 8]; }
  };
  auto sstore = [&](int buf) {
#pragma unroll
    for (int i = 0; i < KPT; ++i) { const int c = tid + i * NT; *(u32x4*)&Ks[buf * KT * LDK + (c >> 3) * LDK + (c & 7) * 8] = kreg[i]; }
#pragma unroll
    for (int i = 0; i < VPT; ++i) {
      const int c = tid + i * NT; const int row = c / VCH, col = c % VCH;
      *(u32x4*)&Vs[buf * 64 * LDV + row * LDV + col * 8] = vreg[i];
    }
  };
  auto compute = [&](int buf) {
    const u16* ks_ = Ks + buf * KT * LDK + r * LDK + h * 8;
    const u16* vs_ = Vs + buf * 64 * LDV + r * LDV + h * 8;
    auto step = [&](int kb, bf16x8 (&kcur)[4], bf16x8 (&knext)[4], bool pre) {
      if (pre) {
#pragma unroll
        for (int ks = 0; ks < 4; ++ks) knext[ks] = *(const bf16x8*)(ks_ + (kb + 1) * 32 * LDK + ks * 16);
      }
      bf16x8 pf0[2], pf1[2];
      {
        f32x16 s0;
#pragma unroll
        for (int q = 0; q < 16; ++q) s0[q] = 0.f;
        s0 = mfma(kcur[0], qf[0], s0);
        s0 = mfma(kcur[1], qf[1], s0);
        float sum = 0.f;
#pragma unroll
        for (int q = 0; q < 16; ++q) { s0[q] = __builtin_amdgcn_exp2f(s0[q]); sum += s0[q]; }
        l0 += sum;
#pragma unroll
        for (int sx = 0; sx < 2; ++sx) {
          u32x4 w = {cvtpk(s0[sx * 8 + 0], s0[sx * 8 + 1]), cvtpk(s0[sx * 8 + 2], s0[sx * 8 + 3]),
                     cvtpk(s0[sx * 8 + 4], s0[sx * 8 + 5]), cvtpk(s0[sx * 8 + 6], s0[sx * 8 + 7])};
          pf0[sx] = __builtin_bit_cast(bf16x8, w);
        }
      }
      {
        f32x16 s1;
#pragma unroll
        for (int q = 0; q < 16; ++q) s1[q] = 0.f;
        s1 = mfma(kcur[2], qf[2], s1);
        s1 = mfma(kcur[3], qf[3], s1);
        float sum = 0.f;
#pragma unroll
        for (int q = 0; q < 16; ++q) { s1[q] = __builtin_amdgcn_exp2f(s1[q]); sum += s1[q]; }
        l1 += sum;
#pragma unroll
        for (int sx = 0; sx < 2; ++sx) {
          u32x4 w = {cvtpk(s1[sx * 8 + 0], s1[sx * 8 + 1]), cvtpk(s1[sx * 8 + 2], s1[sx * 8 + 3]),
                     cvtpk(s1[sx * 8 + 4], s1[sx * 8 + 5]), cvtpk(s1[sx * 8 + 6], s1[sx * 8 + 7])};
          pf1[sx] = __builtin_bit_cast(bf16x8, w);
        }
      }
#pragma unroll
      for (int db = 0; db < 2; ++db)
#pragma unroll
        for (int sx = 0; sx < 2; ++sx) {
          bf16x8 vf = *(const bf16x8*)(vs_ + db * 32 * LDV + (kb * 2 + sx) * 16);
          O0[db] = mfma(vf, pf0[sx], O0[db]);
          O1[db] = mfma(vf, pf1[sx], O1[db]);
        }
    };
    static_assert(KT == 64, "two steps per tile");
    bf16x8 kfa[4], kfb[4];
#pragma unroll
    for (int ks = 0; ks < 4; ++ks) kfa[ks] = *(const bf16x8*)(ks_ + ks * 16);
    step(0, kfa, kfb, true);
    step(1, kfb, kfa, false);
  };
  gload(0); sstore(0);
  __syncthreads();
#pragma unroll 1
  for (int t = 0; t < ntiles; ++t) {
    if (t + 1 < ntiles) gload(t + 1);
    compute(t & 1);
    if (t + 1 < ntiles) sstore((t + 1) & 1);
    __syncthreads();
  }
}

__device__ __forceinline__ void zeroO(f32x16 (&O)[2], float& ls) {
#pragma unroll
  for (int a = 0; a < 2; ++a)
#pragma unroll
    for (int q = 0; q < 16; ++q) O[a][q] = 0.f;
  ls = 0.f;
}

__device__ __forceinline__ void write_gated(u16* __restrict__ mix, size_t tok, int col0, const f32x16 (&O)[2], int h) {
  u16* rowp = mix + tok * 1024 + col0;
#pragma unroll
  for (int db = 0; db < 2; ++db)
#pragma unroll
    for (int g = 0; g < 4; ++g) {
      u16* ptr = rowp + db * 32 + 8 * g + 4 * h;
      u32x2 gv = *(const u32x2*)ptr;
      u32x2 ov = {cvtpk(O[db][4 * g + 0] * bflo(gv[0]), O[db][4 * g + 1] * bfhi(gv[0])),
                  cvtpk(O[db][4 * g + 2] * bflo(gv[1]), O[db][4 * g + 3] * bfhi(gv[1]))};
      *(u32x2*)ptr = ov;
    }
}

#ifndef ATT_ONLY
#define ATT_ONLY -1
#endif
#define ATT_SEL(i) (ATT_ONLY < 0 || ATT_ONLY == (i))
__device__ __forceinline__ void phase_attn(const Params& p, int l, char* smem, bool dry) {
  const u16* proj = (const u16*)(p.ws + OFF_PROJ);
  const u16* qraw = (const u16*)(p.ws + OFF_A);
  const u16* kmla = (const u16*)(p.ws + OFF_KMLA);
  u16* mix = (u16*)(p.ws + OFF_MIX);
  const int tid = threadIdx.x, lane = tid & 63, wave = tid >> 6, r = lane & 31, h = lane >> 5;
  const float lam = ((const float*)(p.ws + OFF_LAM))[l];
  const float lam_init = (l == 0) ? 0.2f : 0.35550906759096927f;
  float* bias_lds = (float*)(smem + ATT_LDS_END);
  constexpr int N_DIFF = 32 * 16, N_MLA = 48 * 16, N_NA = 48 * 16;
  if (ATT_SEL(0))
#pragma unroll 1
  for (int item = vblock(); item < N_DIFF; item += gridDim.x) {
    f32x16 O[2]; float ls;
    {
      const int bh = item >> 4, qt = item & 15;
      const int b = bh >> 2, hd = bh & 3;
      const size_t tok = (size_t)b * S + qt * 256 + wave * 32 + r;
      const size_t tokw = tok - r;
      const u16* Vt = (const u16*)(p.ws + OFF_VD) + (size_t)(b * 4 + hd) * 64 * S;
      f32x16 O1[2]; float ls1;
      zeroO(O, ls); zeroO(O1, ls1);
      diff_pass<64>(proj + tokw * NPS + C_DQ + hd * 64, NPS, proj + (size_t)b * S * NPS + C_DK + hd * 64, NPS, Vt, S / 64, smem, O, O1, ls, ls1);
      const float* sg = p.subln_g + l * 64;
      {
        const float lt0 = ls + __shfl_xor(ls, 32);
        const float lt1 = ls1 + __shfl_xor(ls1, 32);
        const float inv0 = 1.f / lt0;
        const float inv1 = lam / lt1;
        float ss = 0.f;
#pragma unroll
        for (int db = 0; db < 2; ++db)
#pragma unroll
          for (int q = 0; q < 16; ++q) { float o = O[db][q] * inv0 - O1[db][q] * inv1; O[db][q] = o; ss += o * o; }
        ss += __shfl_xor(ss, 32);
        const float rr = rsqrtf(ss * (1.f / 64.f) + EPS) * (1.f - lam_init);
#pragma unroll
        for (int db = 0; db < 2; ++db)
#pragma unroll
          for (int q = 0; q < 16; ++q) O[db][q] *= rr * sg[db * 32 + crow(q, h)];
      }
      if (!dry) write_gated(mix, tok, 768 + hd * 64, O, h);
    }
  }
  if (ATT_SEL(1))
#pragma unroll 1
  for (int it = vblock(); it < N_MLA; it += gridDim.x) {
    f32x16 O[2]; float ls;
    {
      const int bh = it >> 4, qt = it & 15;
      const int b = bh / 6, hh = bh % 6;
      const size_t tok = (size_t)b * S + qt * 256 + wave * 32 + r;
      const size_t tokw = tok - r;
      zeroO(O, ls);
      attn_pass<96, false, 64>(qraw + tokw * 576 + hh * 96, 576, kmla + (size_t)(b * 6 + hh) * S * 96, 96,
                           (const u16*)(p.ws + OFF_VMLA) + (size_t)(b * 6 + hh) * 64 * S, S / 64, smem, O, ls, 0, 0, 0, nullptr);
      {
        const float lt = ls + __shfl_xor(ls, 32);
        const float inv = 1.f / lt;
#pragma unroll
        for (int db = 0; db < 2; ++db)
#pragma unroll
          for (int q = 0; q < 16; ++q) O[db][q] *= inv;
      }
      if (!dry) write_gated(mix, tok, hh * 64, O, h);
    }
  }
  if (ATT_SEL(2))
#pragma unroll 1
  for (int it = vblock(); it < N_NA; it += gridDim.x) {
    f32x16 O[2]; float ls;
    {
      const int bh = it >> 4, rg = it & 15;
      const int b = bh / 6, hh = bh % 6;
      for (int i = tid; i < 15 * 31; i += NT) bias_lds[i] = p.na_rpb[((size_t)l * 6 + hh) * 465 + i] * LOG2E;
      const int rq = rg * 4 + (wave >> 1);
      const int cbase = (wave & 1) * 32;
      const int kr_lo = min(max(rg * 4 - 4, 0), 56);
      const int kr_hi = min(max(rg * 4 + 3 - 4, 0), 56) + 7;
      const int ntiles = kr_hi - kr_lo + 1;
      const size_t tokw = (size_t)b * S + rq * 64 + cbase;
      const size_t tok = tokw + r;
      zeroO(O, ls);
      attn_pass<64, true, 64>(proj + tokw * NPS + C_NAQ + hh * 64, NPS, proj + ((size_t)b * S + kr_lo * 64) * NPS + C_NAK + hh * 64, NPS,
                          (const u16*)(p.ws + OFF_VNA) + (size_t)(b * 6 + hh) * 64 * S + kr_lo * 64, ntiles, smem, O, ls, rq, kr_lo, cbase, bias_lds);
      {
        const float lt = ls + __shfl_xor(ls, 32);
        const float inv = 1.f / lt;
#pragma unroll
        for (int db = 0; db < 2; ++db)
#pragma unroll
          for (int q = 0; q < 16; ++q) O[db][q] *= inv;
      }
      if (!dry) write_gated(mix, tok, 384 + hh * 64, O, h);
    }
  }
}


#define XB_TMO      128
#define XB_XCNT(j)  (256  + 64 * (j))
#define XB_XSUB(j)  (1280 + 64 * (j))
#define XB_XGEN(j)  (2304 + 64 * (j))
#define XB_TOP      3328
#define XB_TOPGEN   3392
#define XCD_BAR_WORDS 3456
#define XB_SPIN_CAP (1u << 22)
#define LAS __attribute__((address_space(3)))
__device__ __forceinline__ unsigned xb_ld(unsigned* p)              { return __hip_atomic_load(p, __ATOMIC_RELAXED, __HIP_MEMORY_SCOPE_AGENT); }
__device__ __forceinline__ unsigned xb_add(unsigned* p, unsigned v) { return __hip_atomic_fetch_add(p, v, __ATOMIC_RELAXED, __HIP_MEMORY_SCOPE_AGENT); }
__device__ __forceinline__ unsigned xb_xcc_id() { return (unsigned)__builtin_amdgcn_s_getreg((3 << 11) | 20) & 0xFu; }
#define XB_SPIN(cond, bar) do { unsigned _sp = 0; while (cond) { __builtin_amdgcn_s_sleep(1); \
    if ((++_sp & 255u) == 0u) { if (xb_ld(&(bar)[XB_TMO])) break; if (_sp > XB_SPIN_CAP) { atomicAdd(&(bar)[XB_TMO], 1u); break; } } } } while (0)
struct XcdBarrier { unsigned* bar; unsigned x; volatile LAS unsigned* st; };
__device__ __forceinline__ XcdBarrier xcd_barrier_post(unsigned* bar, volatile LAS unsigned* st, unsigned& rank) {
  XcdBarrier b; b.bar = bar; b.x = xb_xcc_id(); b.st = st;
  rank = 0u;
  if (threadIdx.x == 0) rank = xb_add(&bar[XB_XCNT(b.x)], 1u);
  return b;
}
__device__ __forceinline__ void xcd_barrier_complete(unsigned* bar, unsigned x, unsigned& nloc, unsigned& nx) {
  const unsigned G = gridDim.x * gridDim.y * gridDim.z;
  unsigned sum, cnt, mine, sp = 0u;
  for (;;) {
    sum = 0u; cnt = 0u; mine = 0u;
#pragma unroll
    for (unsigned j = 0; j < 16; ++j) { const unsigned c = xb_ld(&bar[XB_XCNT(j)]); sum += c; cnt += (c > 0u) ? 1u : 0u; mine = (j == x) ? c : mine; }
    if (sum == G) break;
    __builtin_amdgcn_s_sleep(1);
    if ((++sp & 255u) == 0u) { if (xb_ld(&bar[XB_TMO])) break; if (sp > XB_SPIN_CAP) { atomicAdd(&bar[XB_TMO], 1u); break; } }
  }
  nloc = mine > 0u ? mine : 1u; nx = cnt > 0u ? cnt : 1u;
}
__device__ __forceinline__ void xcd_barrier(const XcdBarrier& b) {
  asm volatile("s_waitcnt vmcnt(0)" ::: "memory");
  __syncthreads();
  if (threadIdx.x == 0) {
    unsigned* bar = b.bar;
    __builtin_amdgcn_s_waitcnt(0);
    unsigned nloc = b.st[0], nx = b.st[1];
    if (nloc == 0u) { xcd_barrier_complete(bar, b.x, nloc, nx); b.st[0] = nloc; b.st[1] = nx; }
    const unsigned old = xb_add(&bar[XB_XSUB(b.x)], 1u);
    const unsigned gen = old / nloc;
    if (old + 1u == (gen + 1u) * nloc) {
      __builtin_amdgcn_fence(__ATOMIC_RELEASE, "agent");
      asm volatile("s_waitcnt vmcnt(0)" ::: "memory");
      const unsigned og = xb_add(&bar[XB_TOP], 1u);
      const unsigned tg = og / nx;
      if (og + 1u == (tg + 1u) * nx) xb_add(&bar[XB_TOPGEN], 1u);
      else XB_SPIN(xb_ld(&bar[XB_TOPGEN]) == tg, bar);
      __builtin_amdgcn_fence(__ATOMIC_ACQUIRE, "agent");
      xb_add(&bar[XB_XGEN(b.x)], 1u);
      asm volatile("s_waitcnt vmcnt(0)" ::: "memory");
    } else {
      XB_SPIN(xb_ld(&bar[XB_XGEN(b.x)]) == gen, bar);
      __builtin_amdgcn_fence(__ATOMIC_ACQUIRE, "agent");
      asm volatile("s_waitcnt vmcnt(0)" ::: "memory");
    }
  }
  __syncthreads();
}

__device__ __forceinline__ void set_vblock(const XcdBarrier& b, unsigned rank) {
  if (threadIdx.x == 0) {
    unsigned pre = 0u, tot = 0u;
#pragma unroll
    for (unsigned j = 0; j < 16; ++j) { const unsigned c = xb_ld(&b.bar[XB_XCNT(j)]); pre += (j < b.x) ? c : 0u; tot += c; }
    s_vb = (tot == gridDim.x) ? (int)(pre + rank) : (int)blockIdx.x;
  }
  __syncthreads();
}

#ifndef ONLY
#define ONLY -1
#endif
template <int PH>
__device__ __forceinline__ void run_phase(const Params& p, char* smem) {
  if (PH == 0) { if (ONLY < 0 || ONLY == 9) phase_prep(p, smem); return; }
  constexpr int l = (PH - 1) / 6, sub = (PH - 1) % 6;
  const int nrep = p.reps[sub];
#pragma unroll 1
  for (int rep = 0; rep < nrep; ++rep) {
    const bool dry = rep + 1 < nrep;
    if (sub == 0) { if (ONLY < 0 || ONLY == 0) phase_norm(p, l); }
    else if (sub == 1) { if (ONLY < 0 || ONLY == 1) phase_gemm1(p, l, smem); }
    else if (sub == 2) { if (ONLY < 0 || ONLY == 2) phase_upproj(p, l, smem); }
    else if (sub == 3) { if (ONLY < 0 || ONLY == 3) phase_post(p, l, smem, dry); }
    else if (sub == 4) { if (ONLY < 0 || ONLY == 4) phase_attn(p, l, smem, dry); }
    else { if (ONLY < 0 || ONLY == 5) phase_gemm2(p, l, smem, dry); }
  }
}

__global__ void __launch_bounds__(512, 2) fwd_kernel(Params p) {
  __shared__ __attribute__((aligned(16))) char smem[SMEM_BYTES];
  __shared__ uint4 xb_words;
  if (threadIdx.x == 0) xb_words = make_uint4(0u, 0u, 0u, 0u);
  __syncthreads();
  unsigned xrank;
  XcdBarrier xb = xcd_barrier_post((unsigned*)(p.ws + OFF_BAR), (volatile LAS unsigned*)&xb_words, xrank);
  if (threadIdx.x == 0) s_vb = blockIdx.x;
  if (p.phase_lo < 0) cg::this_grid().sync();
#define STEP(k) if (p.phase_lo <= (k) && (k) < p.phase_hi) { if ((k) > p.phase_lo) { xcd_barrier(xb); if ((k) == 1) set_vblock(xb, xrank); } run_phase<k>(p, smem); }
  STEP(0) STEP(1) STEP(2) STEP(3) STEP(4) STEP(5) STEP(6) STEP(7) STEP(8) STEP(9) STEP(10) STEP(11) STEP(12)
#undef STEP
}

__global__ void fill_kernel(float* o, int n, float v) {
  for (int i = blockIdx.x * blockDim.x + threadIdx.x; i < n; i += gridDim.x * blockDim.x) o[i] = v;
}

extern "C" void kernel_launch(void* const* d_in, const int* in_sizes, int n_in, void* d_out, int out_size, void* d_ws,
                              size_t ws_size, hipStream_t stream) {
  static int grid_blocks = 0;
  if (!grid_blocks) {
    int dev = 0, cus = 0, per_cu = 0;
    (void)hipGetDevice(&dev);
    (void)hipDeviceGetAttribute(&cus, hipDeviceAttributeMultiprocessorCount, dev);
    (void)hipOccupancyMaxActiveBlocksPerMultiprocessor(&per_cu, fwd_kernel, NT, 0);
    if (per_cu > 1) per_cu = 1;
    if (per_cu < 1) per_cu = 1;
    grid_blocks = cus * per_cu;
  }
  if (ws_size < WS_TOTAL) { fill_kernel<<<1024, 256, 0, stream>>>((float*)d_out, out_size, 100.f); return; }
  Params p{};
  const float** f = (const float**)&p;
  for (int i = 0; i < 23; ++i) f[i] = (const float*)d_in[i];
  p.out = (float*)d_out;
  p.ws = (char*)d_ws;
  { const int reps[6] = {REPS}; for (int i = 0; i < 6; ++i) p.reps[i] = reps[i]; }
#if USE_COOP
  (void)hipMemsetAsync((char*)d_ws + OFF_BAR, 0, SZ_BAR, stream);
  p.phase_lo = 0; p.phase_hi = 13;
  void* args[] = {&p};
  hipError_t e = hipLaunchCooperativeKernel((void*)fwd_kernel, dim3(grid_blocks), dim3(NT), args, 0, stream);
  if (e != hipSuccess) fill_kernel<<<1024, 256, 0, stream>>>((float*)d_out, out_size, 1000.f + (float)(int)e);
#else
  for (int ph = 0; ph < 13; ++ph) {
    p.phase_lo = ph; p.phase_hi = ph + 1;
    fwd_kernel<<<dim3(grid_blocks), dim3(NT), 0, stream>>>(p);
  }
#endif
}
```

```cpp
#include <hip/hip_runtime.h>
#include <hip/hip_cooperative_groups.h>
#include <cstdio>
namespace cg = cooperative_groups;

typedef unsigned short u16;
using bf16x8 = __attribute__((ext_vector_type(8))) short;
using f32x16 = __attribute__((ext_vector_type(16))) float;
using u32x4  = __attribute__((ext_vector_type(4))) unsigned;
using u32x2  = __attribute__((ext_vector_type(2))) unsigned;
#define LAS __attribute__((address_space(3)))

#define USE_COOP 1
#define REPS 1, 1, 1, 1, 1, 1

constexpr int D = 1024, NB = 8, S = 4096, M = NB * S, NL = 2;
constexpr int NIN = 3360, NINP = 3456, NP = 2336;
constexpr int NPS = 2368;
constexpr float EPS = 1e-6f;
constexpr float LOG2E = 1.4426950408889634f;

constexpr int C_CQ = 0, C_CKV = 256, C_KPE = 384, C_NAQ = 416, C_NAK = 800, C_NAV = 1184, C_DQ = 1568, C_DK = 1824, C_DV = 2080;

constexpr int XCD_BAR_WORDS_C = 3456;
constexpr size_t OFF_WIN  = 0;
constexpr size_t SZ_WIN   = (size_t)NL * NINP * 1024 * 2;
constexpr size_t OFF_WUQ  = OFF_WIN + SZ_WIN;
constexpr size_t SZ_WUQ   = (size_t)NL * 640 * 256 * 2;
constexpr size_t OFF_WUKV = OFF_WUQ + SZ_WUQ;
constexpr size_t SZ_WUKV  = (size_t)NL * 768 * 128 * 2;
constexpr size_t OFF_WOUT = OFF_WUKV + SZ_WUKV;
constexpr size_t SZ_WOUT  = (size_t)NL * 1024 * 1024 * 2;
constexpr size_t OFF_MOD  = OFF_WOUT + SZ_WOUT;
constexpr size_t SZ_MOD   = (size_t)NL * NB * 3072 * 4;
constexpr size_t OFF_LAM  = OFF_MOD + SZ_MOD;
constexpr size_t SZ_LAM   = 256;
constexpr size_t OFF_ROPE = OFF_LAM + SZ_LAM;
constexpr size_t SZ_ROPE  = (size_t)S * 16 * 8;
constexpr size_t OFF_A    = OFF_ROPE + SZ_ROPE;
constexpr size_t SZ_QRAW  = (size_t)M * 576 * 2;
constexpr size_t SZ_KVRAW = (size_t)M * 768 * 2;
constexpr size_t SZ_A     = SZ_QRAW + SZ_KVRAW;
constexpr size_t OFF_PROJ = OFF_A + SZ_A;
constexpr size_t SZ_PROJ  = (size_t)M * NPS * 2;
constexpr size_t OFF_KMLA = OFF_PROJ + SZ_PROJ;
constexpr size_t SZ_KMLA  = (size_t)NB * 6 * S * 96 * 2;
constexpr size_t OFF_VMLA = OFF_KMLA + SZ_KMLA;
constexpr size_t SZ_VMLA  = (size_t)NB * 6 * 64 * S * 2;
constexpr size_t OFF_VNA  = OFF_VMLA + SZ_VMLA;
constexpr size_t SZ_VNA   = SZ_VMLA;
constexpr size_t OFF_VD   = OFF_VNA + SZ_VNA;
constexpr size_t SZ_VD    = (size_t)NB * 4 * 64 * S * 2;
constexpr size_t OFF_MIX  = OFF_VD + SZ_VD;
constexpr size_t SZ_MIX   = (size_t)M * 1024 * 2;
constexpr size_t OFF_BAR  = OFF_MIX + SZ_MIX;
constexpr size_t SZ_BAR   = (size_t)XCD_BAR_WORDS_C * 4;
constexpr size_t WS_TOTAL = OFF_BAR + SZ_BAR;
static_assert(WS_TOTAL <= (size_t)512 * 1024 * 1024, "workspace too large");

constexpr int SMEM_BYTES = 147456;
constexpr int NT = 512;

struct Params {
  const float *x, *c, *ada_w, *ada_b, *norm_g, *w_in, *q_lat_g, *w_uq, *kv_lat_g, *w_ukv, *mla_q_g, *mla_k_g,
      *na_q_g, *na_k_g, *na_rpb, *diff_q_g, *diff_k_g, *lam_q1, *lam_k1, *lam_q2, *lam_k2, *subln_g, *w_out;
  float* out;
  char* ws;
  int phase_lo, phase_hi;
  int reps[6];
};

typedef __bf16 bf16x2_t __attribute__((ext_vector_type(2)));
typedef float f32x2_t __attribute__((ext_vector_type(2)));
__device__ __forceinline__ unsigned cvtpk(float lo, float hi) {
  f32x2_t f = {lo, hi};
  bf16x2_t b = __builtin_convertvector(f, bf16x2_t);
  return __builtin_bit_cast(unsigned, b);
}
__device__ __forceinline__ float bflo(unsigned w) { return __uint_as_float(w << 16); }
__device__ __forceinline__ float bfhi(unsigned w) { return __uint_as_float(w & 0xffff0000u); }
__device__ __forceinline__ float silu_f(float v) { return v / (1.f + __expf(-v)); }
__device__ __forceinline__ f32x16 mfma(bf16x8 a, bf16x8 b, f32x16 c) { return __builtin_amdgcn_mfma_f32_32x32x16_bf16(a, b, c, 0, 0, 0); }
__device__ __forceinline__ int crow(int reg, int h) { return (reg & 3) + 8 * (reg >> 2) + 4 * h; }

__device__ __forceinline__ void transpose_tile(const float* __restrict__ src, int K, int N, const float* __restrict__ gain,
                               u16* __restrict__ dst, int kt, int nt, float* lds) {
  const int tid = threadIdx.x;
  for (int i = tid; i < 4096; i += NT) {
    int kk = i >> 6, nn = i & 63;
    int k = kt * 64 + kk, n = nt * 64 + nn;
    float v = (n < N) ? src[(size_t)k * N + n] : 0.f;
    if (gain) v *= gain[k];
    lds[kk * 65 + nn] = v;
  }
  __syncthreads();
  for (int i = tid; i < 512; i += NT) {
    int nn = i >> 3, kc = i & 7;
    float f[8];
#pragma unroll
    for (int j = 0; j < 8; ++j) f[j] = lds[(kc * 8 + j) * 65 + nn];
    u32x4 w = {cvtpk(f[0], f[1]), cvtpk(f[2], f[3]), cvtpk(f[4], f[5]), cvtpk(f[6], f[7])};
    *(u32x4*)&dst[(size_t)(nt * 64 + nn) * K + kt * 64 + kc * 8] = w;
  }
  __syncthreads();
}

__device__ __forceinline__ void mod_item(const Params& p, int item, char* smem) {
  const int l = item / 48, jt = item % 48;
  const int tid = threadIdx.x, jj = tid & 63, kq = tid >> 6;
  float* sc = (float*)smem;
  float* part = sc + 8192;
  for (int i = tid; i < 8192; i += NT) sc[i] = silu_f(p.c[i]);
  __syncthreads();
  float acc[8];
#pragma unroll
  for (int b = 0; b < 8; ++b) acc[b] = 0.f;
  const float* w = p.ada_w + (size_t)l * 1024 * 3072 + jt * 64 + jj;
#pragma unroll 4
  for (int k = kq * 128; k < kq * 128 + 128; ++k) {
    float wv = w[(size_t)k * 3072];
#pragma unroll
    for (int b = 0; b < 8; ++b) acc[b] += sc[b * 1024 + k] * wv;
  }
#pragma unroll
  for (int b = 0; b < 8; ++b) part[(kq * 8 + b) * 64 + jj] = acc[b];
  __syncthreads();
  float* mod = (float*)(p.ws + OFF_MOD);
  for (int i = tid; i < 512; i += NT) {
    int b = i >> 6, j = i & 63;
    float v = 0.f;
#pragma unroll
    for (int q = 0; q < 8; ++q) v += part[(q * 8 + b) * 64 + j];
    v += p.ada_b[l * 3072 + jt * 64 + j];
    mod[((size_t)l * NB + b) * 3072 + jt * 64 + j] = v;
  }
  __syncthreads();
}

__device__ __forceinline__ void rope_item(const Params& p, int item) {
  const int e = item * NT + threadIdx.x;
  const int s = e >> 4, i = e & 15;
  double inv = 1.0;
  for (int j = 0; j < i; ++j) inv *= 0.5623413251903491;
  double rev = (double)s * inv * 0.15915494309189535;
  double fr = rev - floor(rev);
  float f = (float)fr;
  float2 cs;
  cs.x = __builtin_amdgcn_cosf(f);
  cs.y = __builtin_amdgcn_sinf(f);
  ((float2*)(p.ws + OFF_ROPE))[e] = cs;
}

__device__ __forceinline__ void phase_prep(const Params& p, char* smem) {
  constexpr int T_PER_L = 864 + 40 + 24 + 256;
  for (int item = blockIdx.x; item < 2593; item += gridDim.x) {
    if (item < 2 * T_PER_L) {
      int l = item / T_PER_L, t = item % T_PER_L;
      if (t < 864) {
        int kt = t / 54, nt = t % 54;
        transpose_tile(p.w_in + (size_t)l * 1024 * NIN, 1024, NIN, nullptr,
                       (u16*)(p.ws + OFF_WIN) + (size_t)l * NINP * 1024, kt, nt, (float*)smem);
      } else if (t < 904) {
        t -= 864; int kt = t / 10, nt = t % 10;
        transpose_tile(p.w_uq + (size_t)l * 256 * 576, 256, 576, p.q_lat_g + l * 256,
                       (u16*)(p.ws + OFF_WUQ) + (size_t)l * 640 * 256, kt, nt, (float*)smem);
      } else if (t < 928) {
        t -= 904; int kt = t / 12, nt = t % 12;
        transpose_tile(p.w_ukv + (size_t)l * 128 * 768, 128, 768, p.kv_lat_g + l * 128,
                       (u16*)(p.ws + OFF_WUKV) + (size_t)l * 768 * 128, kt, nt, (float*)smem);
      } else {
        t -= 928; int kt = t / 16, nt = t % 16;
        transpose_tile(p.w_out + (size_t)l * 1024 * 1024, 1024, 1024, nullptr,
                       (u16*)(p.ws + OFF_WOUT) + (size_t)l * 1024 * 1024, kt, nt, (float*)smem);
      }
    } else if (item < 2464) {
      mod_item(p, item - 2368, smem);
    } else if (item < 2592) {
      rope_item(p, item - 2464);
    } else {
      if (threadIdx.x < NL) {
        int l = threadIdx.x;
        float s1 = 0.f, s2 = 0.f;
        for (int i = 0; i < 32; ++i) {
          s1 += p.lam_q1[l * 32 + i] * p.lam_k1[l * 32 + i];
          s2 += p.lam_q2[l * 32 + i] * p.lam_k2[l * 32 + i];
        }
        float lam_init = 0.8f - 0.6f * expf(-0.3f * (float)l);
        ((float*)(p.ws + OFF_LAM))[l] = expf(s1) - expf(s2) + lam_init;
      }
    }
  }
}

__device__ __forceinline__ void phase_norm(const Params& p, int l) {
  const float* xin = (l == 0) ? p.x : p.out;
  const float* g = p.norm_g + l * 1024;
  const float* mod = (const float*)(p.ws + OFF_MOD) + (size_t)l * NB * 3072;
  u16* hbuf = (u16*)(p.ws + OFF_A);
  const int lane = threadIdx.x & 63, wave = threadIdx.x >> 6;
  for (int item = blockIdx.x; item < M / 8; item += gridDim.x) {
    const int row = item * 8 + wave;
    const int b = row / S;
    const float* xr = xin + (size_t)row * 1024;
    float v[16];
#pragma unroll
    for (int hf = 0; hf < 2; ++hf) {
      float4 a = *(const float4*)(xr + hf * 512 + lane * 8);
      float4 c = *(const float4*)(xr + hf * 512 + lane * 8 + 4);
      v[hf * 8 + 0] = a.x; v[hf * 8 + 1] = a.y; v[hf * 8 + 2] = a.z; v[hf * 8 + 3] = a.w;
      v[hf * 8 + 4] = c.x; v[hf * 8 + 5] = c.y; v[hf * 8 + 6] = c.z; v[hf * 8 + 7] = c.w;
    }
    float ss = 0.f;
#pragma unroll
    for (int i = 0; i < 16; ++i) ss += v[i] * v[i];
#pragma unroll
    for (int o = 32; o >= 1; o >>= 1) ss += __shfl_xor(ss, o);
    const float rstd = rsqrtf(ss * (1.f / 1024.f) + EPS);
    const float* shift = mod + (size_t)b * 3072;
    const float* scale = shift + 1024;
#pragma unroll
    for (int hf = 0; hf < 2; ++hf) {
      const int c0 = hf * 512 + lane * 8;
      float o[8];
#pragma unroll
      for (int j = 0; j < 8; ++j) o[j] = v[hf * 8 + j] * rstd * g[c0 + j] * (1.f + scale[c0 + j]) + shift[c0 + j];
      u32x4 w = {cvtpk(o[0], o[1]), cvtpk(o[2], o[3]), cvtpk(o[4], o[5]), cvtpk(o[6], o[7])};
      *(u32x4*)&hbuf[(size_t)row * 1024 + c0] = w;
    }
  }
}

template <bool STAGED, int NK, class Tr, class Dst, class Epi>
__device__ __forceinline__ void gemm_tile(const u16* __restrict__ A, int lda, const u16* __restrict__ Bt, int ldb,
                                          int m0, int n0, char* smem, Tr tr, Dst dstf, Epi epi) {
  constexpr int LDT = 72;
  constexpr int STAGE = (256 + 128) * LDT;
  u16* As = (u16*)smem;
  u16* Bs = As + 256 * LDT;
  const int tid = threadIdx.x, lane = tid & 63, wave = tid >> 6;
  const int wm = wave >> 1, wn = wave & 1;
  const int r = lane & 31, h = lane >> 5;
  f32x16 acc[2][2];
#pragma unroll
  for (int i = 0; i < 2; ++i)
#pragma unroll
    for (int j = 0; j < 2; ++j)
#pragma unroll
      for (int q = 0; q < 16; ++q) acc[i][j][q] = 0.f;
  constexpr int nk = NK;
  u32x4 ra0[4], rb0[2], ra1[4], rb1[2];
  const int lrow = tid >> 3, lkc = tid & 7;
  const u16* Ap = A + (size_t)(m0 + lrow) * lda + lkc * 8;
  const u16* Bp = Bt + (size_t)(n0 + lrow) * ldb + lkc * 8;
#define GLOAD(RA, RB, kt) { _Pragma("unroll") for (int i = 0; i < 4; ++i) RA[i] = *(const u32x4*)(Ap + (size_t)(i * 64) * lda + (kt) * 64); \
                            _Pragma("unroll") for (int i = 0; i < 2; ++i) RB[i] = *(const u32x4*)(Bp + (size_t)(i * 64) * ldb + (kt) * 64); }
#define SSTORE(RA, RB, buf) { _Pragma("unroll") for (int i = 0; i < 4; ++i) *(u32x4*)&As[(buf) * STAGE + (lrow + i * 64) * LDT + lkc * 8] = RA[i]; \
                              _Pragma("unroll") for (int i = 0; i < 2; ++i) *(u32x4*)&Bs[(buf) * STAGE + (lrow + i * 64) * LDT + lkc * 8] = RB[i]; }
  auto compute = [&](int buf) {
    const u16* as = As + buf * STAGE + (wm * 64 + r) * LDT + h * 8;
    const u16* bs = Bs + buf * STAGE + (wn * 64 + r) * LDT + h * 8;
#pragma unroll
    for (int ks = 0; ks < 4; ++ks) {
      bf16x8 a0 = *(const bf16x8*)(as + ks * 16);
      bf16x8 a1 = *(const bf16x8*)(as + 32 * LDT + ks * 16);
      bf16x8 b0 = *(const bf16x8*)(bs + ks * 16);
      bf16x8 b1 = *(const bf16x8*)(bs + 32 * LDT + ks * 16);
      acc[0][0] = mfma(a0, b0, acc[0][0]);
      acc[0][1] = mfma(a0, b1, acc[0][1]);
      acc[1][0] = mfma(a1, b0, acc[1][0]);
      acc[1][1] = mfma(a1, b1, acc[1][1]);
    }
  };
  GLOAD(ra0, rb0, 0);
  SSTORE(ra0, rb0, 0);
  GLOAD(ra1, rb1, 1);
  __syncthreads();
#pragma unroll
  for (int kt = 0; kt < nk; kt += 2) {
    if (kt + 2 < nk) GLOAD(ra0, rb0, kt + 2);
    compute(0);
    SSTORE(ra1, rb1, 1);
    __syncthreads();
    if (kt + 3 < nk) GLOAD(ra1, rb1, kt + 3);
    compute(1);
    if (kt + 2 < nk) SSTORE(ra0, rb0, 0);
    __syncthreads();
  }
#undef GLOAD
#undef SSTORE
  if (STAGED) {
    u16* Cw = (u16*)smem + wave * (64 * 72);
    const bool odd = lane & 1;
#pragma unroll
    for (int mb = 0; mb < 2; ++mb)
#pragma unroll
      for (int nb = 0; nb < 2; ++nb) {
        const int cl = nb * 32 + r;
        const int gcol = n0 + wn * 64 + cl;
#pragma unroll
        for (int q = 0; q < 16; q += 2) {
          const float a = tr(gcol, acc[mb][nb][q]), b = tr(gcol, acc[mb][nb][q + 1]);
          const float x = odd ? a : b;
          const float y = __int_as_float(__builtin_amdgcn_update_dpp(0, __float_as_int(x), 0xB1, 0xF, 0xF, true));
          const unsigned pk = odd ? cvtpk(y, b) : cvtpk(a, y);
          const int rl = mb * 32 + crow(q, h) + (odd ? 1 : 0);
          *(unsigned*)&Cw[rl * 72 + (cl & ~1)] = pk;
        }
      }
    __syncthreads();
#pragma unroll
    for (int i = 0; i < 8; ++i) {
      const int id = lane + i * 64;
      const int row = id >> 3, ch = id & 7;
      u32x4 v = *(const u32x4*)&Cw[row * 72 + ch * 8];
      u16* d = dstf(m0 + wm * 64 + row, n0 + wn * 64 + ch * 8);
      if (d) *(u32x4*)d = v;
    }
    __syncthreads();
  } else {
#pragma unroll
    for (int mb = 0; mb < 2; ++mb)
#pragma unroll
      for (int nb = 0; nb < 2; ++nb) {
        const int col = n0 + wn * 64 + nb * 32 + r;
#pragma unroll
        for (int q = 0; q < 16; ++q) {
          const int row = m0 + wm * 64 + mb * 32 + crow(q, h);
          epi(row, col, acc[mb][nb][q]);
        }
      }
  }
}

template <bool STAGED, int NK, class Tr, class Dst, class Epi>
__device__ __forceinline__ void gemm_tile_glds(const u16* __restrict__ A, int lda, const u16* __restrict__ Bt, int ldb,
                                               int m0, int n0, char* smem, Tr tr, Dst dstf, Epi epi) {
  constexpr int STAGE_B = (256 + 128) * 128;
  const int tid = threadIdx.x, lane = tid & 63, wave = tid >> 6;
  const int wm = wave >> 1, wn = wave & 1;
  const int r = lane & 31, h = lane >> 5;
  f32x16 acc[2][2];
#pragma unroll
  for (int i = 0; i < 2; ++i)
#pragma unroll
    for (int j = 0; j < 2; ++j)
#pragma unroll
      for (int q = 0; q < 16; ++q) acc[i][j][q] = 0.f;
  const int srow = tid >> 3, sslot = tid & 7;
  const int scol = (sslot ^ ((srow >> 1) & 7)) * 8;
  const u16* Ap = A + (size_t)(m0 + srow) * lda + scol;
  const u16* Bp = Bt + (size_t)(n0 + srow) * ldb + scol;
  const unsigned lds0 = (unsigned)__builtin_amdgcn_readfirstlane((int)((unsigned)(size_t)(const volatile LAS void*)smem + (unsigned)(tid >> 6) * 1024u));
  auto stage = [&](int kt, int buf) {
#pragma unroll
    for (int i = 0; i < 4; ++i) {
      const void* g = (const void*)(Ap + (size_t)(i * 64) * lda + kt * 64);
      const unsigned d = lds0 + (unsigned)(buf * STAGE_B + i * 8192);
      unsigned keep;
      asm volatile("s_mov_b32 %0, m0\n\ts_mov_b32 m0, %2\n\ts_nop 0\n\tglobal_load_lds_dwordx4 %1, off\n\ts_mov_b32 m0, %0" : "=&s"(keep) : "v"(g), "s"(d) : "memory");
    }
#pragma unroll
    for (int i = 0; i < 2; ++i) {
      const void* g = (const void*)(Bp + (size_t)(i * 64) * ldb + kt * 64);
      const unsigned d = lds0 + (unsigned)(buf * STAGE_B + 32768 + i * 8192);
      unsigned keep;
      asm volatile("s_mov_b32 %0, m0\n\ts_mov_b32 m0, %2\n\ts_nop 0\n\tglobal_load_lds_dwordx4 %1, off\n\ts_mov_b32 m0, %0" : "=&s"(keep) : "v"(g), "s"(d) : "memory");
    }
  };
  const int arow0 = wm * 64 + r, brow0 = wn * 64 + r;
  const int asw0 = (arow0 >> 1) & 7, asw1 = ((arow0 + 32) >> 1) & 7;
  const int bsw0 = (brow0 >> 1) & 7, bsw1 = ((brow0 + 32) >> 1) & 7;
  auto compute = [&](int buf) {
    const char* as = smem + buf * STAGE_B;
    const char* bs = as + 32768;
    bf16x8 fa0[2], fa1[2], fb0[2], fb1[2];
    auto ldfrag = [&](int ks, int s) {
      const int c = ks * 2 + h;
      fa0[s] = *(const bf16x8*)(as + arow0 * 128 + ((c ^ asw0) << 4));
      fa1[s] = *(const bf16x8*)(as + (arow0 + 32) * 128 + ((c ^ asw1) << 4));
      fb0[s] = *(const bf16x8*)(bs + brow0 * 128 + ((c ^ bsw0) << 4));
      fb1[s] = *(const bf16x8*)(bs + (brow0 + 32) * 128 + ((c ^ bsw1) << 4));
    };
    ldfrag(0, 0);
#pragma unroll
    for (int ks = 0; ks < 4; ++ks) {
      if (ks + 1 < 4) ldfrag(ks + 1, (ks + 1) & 1);
      __builtin_amdgcn_sched_barrier(0);
      const int s = ks & 1;
      acc[0][0] = mfma(fa0[s], fb0[s], acc[0][0]);
      acc[0][1] = mfma(fa0[s], fb1[s], acc[0][1]);
      acc[1][0] = mfma(fa1[s], fb0[s], acc[1][0]);
      acc[1][1] = mfma(fa1[s], fb1[s], acc[1][1]);
      __builtin_amdgcn_sched_barrier(0);
    }
  };
  stage(0, 0);
  stage(1, 1);
#pragma unroll
  for (int kt = 0; kt < NK; ++kt) {
    if (kt + 1 < NK) asm volatile("s_waitcnt vmcnt(6)" ::: "memory");
    else             asm volatile("s_waitcnt vmcnt(0)" ::: "memory");
    asm volatile("s_waitcnt lgkmcnt(0)" ::: "memory");
    __builtin_amdgcn_s_barrier();
    asm volatile("" ::: "memory");
    if (kt + 2 < NK) stage(kt + 2, (kt + 2) % 3);
    compute(kt % 3);
  }
  asm volatile("s_waitcnt lgkmcnt(0)" ::: "memory");
  __builtin_amdgcn_s_barrier();
  asm volatile("" ::: "memory");
  if (STAGED) {
    u16* Cw = (u16*)smem + wave * (64 * 72);
    const bool odd = lane & 1;
#pragma unroll
    for (int mb = 0; mb < 2; ++mb)
#pragma unroll
      for (int nb = 0; nb < 2; ++nb) {
        const int cl = nb * 32 + r;
        const int gcol = n0 + wn * 64 + cl;
#pragma unroll
        for (int q = 0; q < 16; q += 2) {
          const float a = tr(gcol, acc[mb][nb][q]), b = tr(gcol, acc[mb][nb][q + 1]);
          const float x = odd ? a : b;
          const float y = __int_as_float(__builtin_amdgcn_update_dpp(0, __float_as_int(x), 0xB1, 0xF, 0xF, true));
          const unsigned pk = odd ? cvtpk(y, b) : cvtpk(a, y);
          const int rl = mb * 32 + crow(q, h) + (odd ? 1 : 0);
          *(unsigned*)&Cw[rl * 72 + (cl & ~1)] = pk;
        }
      }
    __syncthreads();
#pragma unroll
    for (int i = 0; i < 8; ++i) {
      const int id = lane + i * 64;
      const int row = id >> 3, ch = id & 7;
      u32x4 v = *(const u32x4*)&Cw[row * 72 + ch * 8];
      u16* d = dstf(m0 + wm * 64 + row, n0 + wn * 64 + ch * 8);
      if (d) *(u32x4*)d = v;
    }
    __syncthreads();
  } else {
#pragma unroll
    for (int mb = 0; mb < 2; ++mb)
#pragma unroll
      for (int nb = 0; nb < 2; ++nb) {
        const int col = n0 + wn * 64 + nb * 32 + r;
#pragma unroll
        for (int q = 0; q < 16; ++q) {
          const int row = m0 + wm * 64 + mb * 32 + crow(q, h);
          epi(row, col, acc[mb][nb][q]);
        }
      }
    __syncthreads();
  }
}

__shared__ int s_vb;
__device__ __forceinline__ int vblock() { return s_vb; }

__device__ __forceinline__ void phase_gemm1(const Params& p, int l, char* smem) {
  const u16* A = (const u16*)(p.ws + OFF_A);
  const u16* Bt = (const u16*)(p.ws + OFF_WIN) + (size_t)l * NINP * 1024;
  u16* proj = (u16*)(p.ws + OFF_PROJ);
  u16* mix = (u16*)(p.ws + OFF_MIX);
  for (int t = vblock(); t < 128 * 27; t += gridDim.x) {
    const int mt = t / 27, nt = t % 27;
    gemm_tile_glds<true, 16>(A, 1024, Bt, 1024, mt * 256, nt * 128, smem,
      [&](int col, float v) { return (col >= NP) ? silu_f(v) : v; },
      [&](int row, int col8) -> u16* { return (col8 < NP) ? proj + (size_t)row * NPS + col8 : ((col8 < NIN) ? mix + (size_t)row * 1024 + (col8 - NP) : (u16*)nullptr); },
      [&](int, int, float) {});
  }
}

__device__ __forceinline__ void phase_upproj(const Params& p, int l, char* smem) {
  const u16* proj = (const u16*)(p.ws + OFF_PROJ);
  u16* qraw = (u16*)(p.ws + OFF_A);
  u16* kvraw = (u16*)(p.ws + OFF_A + SZ_QRAW);
  const u16* wuq = (const u16*)(p.ws + OFF_WUQ) + (size_t)l * 640 * 256;
  const u16* wukv = (const u16*)(p.ws + OFF_WUKV) + (size_t)l * 768 * 128;
  for (int t = vblock(); t < 128 * 11; t += gridDim.x) {
    const int mt = t / 11, nt = t % 11;
    if (nt < 5) {
      gemm_tile<true, 4>(proj + C_CQ, NPS, wuq, 256, mt * 256, nt * 128, smem,
        [&](int, float v) { return v; },
        [&](int row, int col8) -> u16* { return (col8 < 576) ? qraw + (size_t)row * 576 + col8 : (u16*)nullptr; },
        [&](int, int, float) {});
    } else {
      gemm_tile<true, 2>(proj + C_CKV, NPS, wukv, 128, mt * 256, (nt - 5) * 128, smem,
        [&](int, float v) { return v; },
        [&](int row, int col8) -> u16* { return kvraw + (size_t)row * 768 + col8; },
        [&](int, int, float) {});
    }
  }
}

__device__ __forceinline__ void phase_gemm2(const Params& p, int l, char* smem, bool dry) {
  const u16* A = (const u16*)(p.ws + OFF_MIX);
  const u16* Bt = (const u16*)(p.ws + OFF_WOUT) + (size_t)l * 1024 * 1024;
  const float* xin = (l == 0) ? p.x : p.out;
  const float* gate = (const float*)(p.ws + OFF_MOD) + (size_t)l * NB * 3072 + 2048;
  float* out = p.out;
  for (int t = vblock(); t < 128 * 8; t += gridDim.x) {
    const int mt = t / 8, nt = t % 8;
    const int b = (mt * 256) / S;
    const float* gb = gate + (size_t)b * 3072;
    gemm_tile_glds<false, 16>(A, 1024, Bt, 1024, mt * 256, nt * 128, smem,
      [&](int, float v) { return v; }, [&](int, int) -> u16* { return nullptr; },
      [&](int row, int col, float v) {
        const size_t idx = (size_t)row * 1024 + col;
        float o = xin[idx] + gb[col] * v;
        if (!dry) out[idx] = o;
      });
  }
}

template <int N8>
__device__ __forceinline__ void ld_bf16(const u16* __restrict__ ptr, float* v, float sc) {
#pragma unroll
  for (int c = 0; c < N8; ++c) {
    u32x4 w = *(const u32x4*)(ptr + c * 8);
#pragma unroll
    for (int j = 0; j < 4; ++j) { v[c * 8 + 2 * j] = bflo(w[j]) * sc; v[c * 8 + 2 * j + 1] = bfhi(w[j]) * sc; }
  }
}
template <int N8>
__device__ __forceinline__ void st_bf16v(u16* __restrict__ ptr, const float* v) {
#pragma unroll
  for (int c = 0; c < N8; ++c) {
    u32x4 w = {cvtpk(v[c * 8 + 0], v[c * 8 + 1]), cvtpk(v[c * 8 + 2], v[c * 8 + 3]), cvtpk(v[c * 8 + 4], v[c * 8 + 5]), cvtpk(v[c * 8 + 6], v[c * 8 + 7])};
    *(u32x4*)(ptr + c * 8) = w;
  }
}
typedef const float __attribute__((address_space(4))) * cfptr;
template <int N8, bool ROPE>
__device__ __forceinline__ void unit_proc(u32x4* w, float sc0, float sc1, const float* __restrict__ g_, const float2* __restrict__ cs, float outscale) {
  cfptr g = (cfptr)g_;
  constexpr int DD = N8 * 8;
  constexpr int NR = ROPE ? N8 - 4 : N8;
  float ss = 0.f;
#pragma unroll
  for (int c = 0; c < N8; ++c) {
    const float sc = (c < NR) ? sc0 : sc1;
#pragma unroll
    for (int j = 0; j < 4; ++j) { float a = bflo(w[c][j]) * sc, b = bfhi(w[c][j]) * sc; ss += a * a + b * b; }
  }
  const float rr = rsqrtf(ss * (1.f / DD) + EPS);
#pragma unroll
  for (int c = 0; c < NR; ++c) {
    const float sc = sc0 * rr;
#pragma unroll
    for (int j = 0; j < 4; ++j) {
      float a = bflo(w[c][j]) * sc * g[c * 8 + 2 * j] * outscale, b = bfhi(w[c][j]) * sc * g[c * 8 + 2 * j + 1] * outscale;
      w[c][j] = cvtpk(a, b);
    }
  }
  if (ROPE) {
    float v[32];
    const float sc = sc1 * rr;
#pragma unroll
    for (int c = 0; c < 4; ++c)
#pragma unroll
      for (int j = 0; j < 4; ++j) {
        v[c * 8 + 2 * j] = bflo(w[NR + c][j]) * sc * g[(NR + c) * 8 + 2 * j];
        v[c * 8 + 2 * j + 1] = bfhi(w[NR + c][j]) * sc * g[(NR + c) * 8 + 2 * j + 1];
      }
#pragma unroll
    for (int i = 0; i < 16; ++i) {
      float2 c = cs[i];
      float x1 = v[i], x2 = v[16 + i];
      v[i] = (x1 * c.x - x2 * c.y) * outscale;
      v[16 + i] = (x2 * c.x + x1 * c.y) * outscale;
    }
#pragma unroll
    for (int c = 0; c < 4; ++c)
#pragma unroll
      for (int j = 0; j < 4; ++j) w[NR + c][j] = cvtpk(v[c * 8 + 2 * j], v[c * 8 + 2 * j + 1]);
  }
}
template <int N8>
__device__ __forceinline__ void ldw(const u16* __restrict__ ptr, u32x4* w) {
#pragma unroll
  for (int c = 0; c < N8; ++c) w[c] = *(const u32x4*)(ptr + c * 8);
}
template <int N8>
__device__ __forceinline__ void stw(u16* __restrict__ ptr, const u32x4* w, bool dry) {
  if (dry) return;
#pragma unroll
  for (int c = 0; c < N8; ++c) *(u32x4*)(ptr + c * 8) = w[c];
}

__device__ __forceinline__ void phase_post(const Params& p, int l, char* smem, bool dry) {
  u16* proj = (u16*)(p.ws + OFF_PROJ);
  u16* qraw = (u16*)(p.ws + OFF_A);
  const u16* kvraw = (const u16*)(p.ws + OFF_A + SZ_QRAW);
  u16* kmla = (u16*)(p.ws + OFF_KMLA);
  const float2* rope = (const float2*)(p.ws + OFF_ROPE);
  float* rstd_q = (float*)smem;
  float* rstd_kv = rstd_q + 64;
  u16* tbuf = (u16*)(smem + 512);
  const int tid = threadIdx.x, lane = tid & 63, wave = tid >> 6;
  for (int item = blockIdx.x; item < M / 64; item += gridDim.x) {
    const int t0 = item * 64;
    const int b = t0 / S, s0 = t0 % S;
    {
      const int tok = tid >> 3, part = tid & 7;
      const u16* pr = proj + (size_t)(t0 + tok) * NPS;
      float v[32];
      ld_bf16<4>(pr + C_CQ + part * 32, v, 1.f);
      float sq = 0.f;
#pragma unroll
      for (int i = 0; i < 32; ++i) sq += v[i] * v[i];
      ld_bf16<2>(pr + C_CKV + part * 16, v, 1.f);
      float skv = 0.f;
#pragma unroll
      for (int i = 0; i < 16; ++i) skv += v[i] * v[i];
      sq += __shfl_xor(sq, 1); sq += __shfl_xor(sq, 2); sq += __shfl_xor(sq, 4);
      skv += __shfl_xor(skv, 1); skv += __shfl_xor(skv, 2); skv += __shfl_xor(skv, 4);
      if (part == 0) {
        rstd_q[tok] = rsqrtf(sq * (1.f / 256.f) + EPS);
        rstd_kv[tok] = rsqrtf(skv * (1.f / 128.f) + EPS);
      }
    }
    __syncthreads();
    {
      const int tok = lane;
      const int t = t0 + tok;
      const float2* cs = rope + (size_t)(s0 + tok) * 16;
      u16* pr = proj + (size_t)t * NPS;
#pragma unroll 1
      for (int u = 0 + ((wave - 0) & 7); u < 6; u += 8) {
        u32x4 w[12];
        u16* ptr = qraw + (size_t)t * 576 + u * 96;
        ldw<12>(ptr, w);
        unit_proc<12, true>(w, rstd_q[tok], rstd_q[tok], p.mla_q_g + l * 96, cs, 0.10206207261596575f * LOG2E);
        stw<12>(ptr, w, dry);
      }
#pragma unroll 1
      for (int u = 6 + ((wave - 6) & 7); u < 12; u += 8) {
        const int hh = u - 6;
        u32x4 w[12];
        ldw<8>(kvraw + (size_t)t * 768 + hh * 128, w);
        ldw<4>(pr + C_KPE, w + 8);
        unit_proc<12, true>(w, rstd_kv[tok], 1.f, p.mla_k_g + l * 96, cs, 1.f);
        stw<12>(kmla + ((size_t)(b * 6 + hh) * S + s0 + tok) * 96, w, dry);
      }
#pragma unroll 1
      for (int u = 12 + ((wave - 12) & 7); u < 18; u += 8) {
        u32x4 w[8];
        u16* ptr = pr + C_NAQ + (u - 12) * 64;
        ldw<8>(ptr, w);
        unit_proc<8, false>(w, 1.f, 1.f, p.na_q_g + l * 64, cs, 0.125f * LOG2E);
        stw<8>(ptr, w, dry);
      }
#pragma unroll 1
      for (int u = 18 + ((wave - 18) & 7); u < 24; u += 8) {
        u32x4 w[8];
        u16* ptr = pr + C_NAK + (u - 18) * 64;
        ldw<8>(ptr, w);
        unit_proc<8, false>(w, 1.f, 1.f, p.na_k_g + l * 64, cs, 1.f);
        stw<8>(ptr, w, dry);
      }
#pragma unroll 1
      for (int u = 24 + ((wave - 24) & 7); u < 32; u += 8) {
        u32x4 w[4];
        u16* ptr = pr + C_DQ + (u - 24) * 32;
        ldw<4>(ptr, w);
        unit_proc<4, true>(w, 1.f, 1.f, p.diff_q_g + l * 32, cs, 0.17677669529663687f * LOG2E);
        stw<4>(ptr, w, dry);
      }
#pragma unroll 1
      for (int u = 32 + ((wave - 32) & 7); u < 40; u += 8) {
        u32x4 w[4];
        u16* ptr = pr + C_DK + (u - 32) * 32;
        ldw<4>(ptr, w);
        unit_proc<4, true>(w, 1.f, 1.f, p.diff_k_g + l * 32, cs, 1.f);
        stw<4>(ptr, w, dry);
      }
    }
    {
      u16* T = tbuf + wave * (64 * 72);
      const int plane = (lane & ~15) | ((lane & 3) | ((lane & 4) << 1) | ((lane & 8) >> 1));
#pragma unroll 1
      for (int mi = wave; mi < 16; mi += 8) {
        const u16* src; u16* dst; float sc = 1.f;
        const int t = t0 + lane;
        if (mi < 6) {
          src = kvraw + (size_t)t * 768 + mi * 128 + 64; sc = rstd_kv[lane];
          dst = (u16*)(p.ws + OFF_VMLA) + (size_t)(b * 6 + mi) * 64 * S + s0;
        } else if (mi < 12) {
          src = proj + (size_t)t * NPS + C_NAV + (mi - 6) * 64;
          dst = (u16*)(p.ws + OFF_VNA) + (size_t)(b * 6 + (mi - 6)) * 64 * S + s0;
        } else {
          src = proj + (size_t)t * NPS + C_DV + (mi - 12) * 64;
          dst = (u16*)(p.ws + OFF_VD) + (size_t)(b * 4 + (mi - 12)) * 64 * S + s0;
        }
#pragma unroll
        for (int c = 0; c < 8; ++c) {
          u32x4 w = *(const u32x4*)(src + c * 8);
#pragma unroll
          for (int j = 0; j < 4; ++j) {
            unsigned pk = cvtpk(bflo(w[j]) * sc, bfhi(w[j]) * sc);
            T[(c * 8 + 2 * j) * 72 + plane] = (u16)(pk & 0xffffu);
            T[(c * 8 + 2 * j + 1) * 72 + plane] = (u16)(pk >> 16);
          }
        }
        __syncthreads();
#pragma unroll
        for (int c = 0; c < 8; ++c) {
          u32x4 w = *(const u32x4*)&T[lane * 72 + c * 8];
          if (!dry) *(u32x4*)(dst + (size_t)lane * S + c * 8) = w;
        }
        __syncthreads();
      }
    }
    __syncthreads();
  }
}

constexpr int ATT_VS_OFF = 2 * 128 * 104 * 2;
constexpr int ATT_LDS_END = ATT_VS_OFF + 2 * 64 * 136 * 2;
template <int DQK, bool NA, int KT>
__device__ __forceinline__ void attn_pass(const u16* __restrict__ Qw, int ldq, const u16* __restrict__ Kg, int ldk,
                                          const u16* __restrict__ Vt, int ntiles, char* smem, f32x16 (&O)[2],
                                          float& lsum, int rq, int kr_lo, int cbase, const float* __restrict__ bias_lds) {
  constexpr int LDK = DQK + 8, LDV = KT + 8;
  constexpr int KCH = DQK / 8;
  constexpr int KPT = (KT * KCH + NT - 1) / NT;
  constexpr int VCH = KT / 8;
  constexpr int VPT = 64 * VCH / NT;
  constexpr int NKS = DQK / 16;
  u16* Ks = (u16*)smem;
  u16* Vs = (u16*)(smem + ATT_VS_OFF);
  const int tid = threadIdx.x, lane = tid & 63, r = lane & 31, h = lane >> 5;
  bf16x8 qf[NKS];
#pragma unroll
  for (int ks = 0; ks < NKS; ++ks) qf[ks] = *(const bf16x8*)&Qw[(size_t)r * ldq + ks * 16 + h * 8];
  u32x4 kreg[KPT], vreg[VPT];
  auto gload = [&](int t) {
#pragma unroll
    for (int i = 0; i < KPT; ++i) {
      const int c = tid + i * NT;
      if (c < KT * KCH) {
        const int row = c / KCH, col = c % KCH;
        kreg[i] = *(const u32x4*)&Kg[(size_t)(t * KT + row) * ldk + col * 8];
      }
    }
#pragma unroll
    for (int i = 0; i < VPT; ++i) {
      const int c = tid + i * NT;
      const int row = c / VCH, col = c % VCH;
      vreg[i] = *(const u32x4*)&Vt[(size_t)row * S + t * KT + col * 8];
    }
  };
  auto sstore = [&](int buf) {
#pragma unroll
    for (int i = 0; i < KPT; ++i) {
      const int c = tid + i * NT;
      if (c < KT * KCH) {
        const int row = c / KCH, col = c % KCH;
        *(u32x4*)&Ks[buf * KT * LDK + row * LDK + col * 8] = kreg[i];
      }
    }
#pragma unroll
    for (int i = 0; i < VPT; ++i) {
      const int c = tid + i * NT;
      const int row = c / VCH, col = c % VCH;
      *(u32x4*)&Vs[buf * 64 * LDV + row * LDV + col * 8] = vreg[i];
    }
  };
  auto compute = [&](int buf, int t) {
    const u16* ks_ = Ks + buf * KT * LDK + r * LDK + h * 8;
    const u16* vs_ = Vs + buf * 64 * LDV + r * LDV + h * 8;
    auto step = [&](int kb, bf16x8 (&kcur)[NKS], bf16x8 (&knext)[NKS], bool pre) {
      bf16x8 vfr[4];
#pragma unroll
      for (int db = 0; db < 2; ++db)
#pragma unroll
        for (int sx = 0; sx < 2; ++sx) vfr[db * 2 + sx] = *(const bf16x8*)(vs_ + db * 32 * LDV + (kb * 2 + sx) * 16);
      if (pre) {
#pragma unroll
        for (int ks = 0; ks < NKS; ++ks) knext[ks] = *(const bf16x8*)(ks_ + (kb + 1) * 32 * LDK + ks * 16);
      }
      f32x16 s;
#pragma unroll
      for (int q = 0; q < 16; ++q) s[q] = 0.f;
#pragma unroll
      for (int ks = 0; ks < NKS; ++ks) s = mfma(kcur[ks], qf[ks], s);
      float pv[16];
      if (NA) {
        const int c = cbase + r;
        const int c0 = min(max(c - 8, 0), 48);
        const int dr = (kr_lo + t) - rq + 7;
#pragma unroll
        for (int q = 0; q < 16; ++q) {
          const int kc = kb * 32 + crow(q, h);
          const bool valid = (unsigned)(kc - c0) < 16u;
          const int bi = valid ? (dr * 31 + kc - c + 15) : 0;
          const float e = __builtin_amdgcn_exp2f(s[q] + bias_lds[bi]);
          pv[q] = valid ? e : 0.f;
        }
      } else {
#pragma unroll
        for (int q = 0; q < 16; ++q) pv[q] = __builtin_amdgcn_exp2f(s[q]);
      }
      lsum += ((pv[0] + pv[1]) + (pv[2] + pv[3])) + ((pv[4] + pv[5]) + (pv[6] + pv[7])) +
              (((pv[8] + pv[9]) + (pv[10] + pv[11])) + ((pv[12] + pv[13]) + (pv[14] + pv[15])));
      bf16x8 pf[2];
#pragma unroll
      for (int sx = 0; sx < 2; ++sx) {
        u32x4 w = {cvtpk(pv[sx * 8 + 0], pv[sx * 8 + 1]), cvtpk(pv[sx * 8 + 2], pv[sx * 8 + 3]),
                   cvtpk(pv[sx * 8 + 4], pv[sx * 8 + 5]), cvtpk(pv[sx * 8 + 6], pv[sx * 8 + 7])};
        pf[sx] = __builtin_bit_cast(bf16x8, w);
      }
#pragma unroll
      for (int db = 0; db < 2; ++db)
#pragma unroll
        for (int sx = 0; sx < 2; ++sx) {
          O[db] = mfma(vfr[db * 2 + sx], pf[sx], O[db]);
        }
    };
    bf16x8 kfa[NKS], kfb[NKS];
#pragma unroll
    for (int ks = 0; ks < NKS; ++ks) kfa[ks] = *(const bf16x8*)(ks_ + ks * 16);
#pragma unroll 1
    for (int kb = 0; kb < KT / 32; kb += 2) {
      step(kb, kfa, kfb, true);
      step(kb + 1, kfb, kfa, kb + 2 < KT / 32);
    }
  };
  gload(0); sstore(0);
  __syncthreads();
#pragma unroll 1
  for (int t = 0; t < ntiles; ++t) {
    if (t + 1 < ntiles) gload(t + 1);
    bool act = true;
    if (NA) { const int r0 = min(max(rq - 4, 0), 56); const int kr = kr_lo + t; act = (kr >= r0) && (kr < r0 + 8); }
    if (act) compute(t & 1, t);
    if (t + 1 < ntiles) sstore((t + 1) & 1);
    __syncthreads();
  }
}

template <int KT>
__device__ __forceinline__ void diff_pass(const u16* __restrict__ Qw, int ldq, const u16* __restrict__ Kg, int ldk,
                                          const u16* __restrict__ Vt, int ntiles, char* smem, f32x16 (&O0)[2], f32x16 (&O1)[2],
                                          float& l0, float& l1) {
  constexpr int LDK = 72, LDV = KT + 8;
  constexpr int KPT = KT * 8 / NT;
  constexpr int VCH = KT / 8;
  constexpr int VPT = 64 * VCH / NT;
  u16* Ks = (u16*)smem;
  u16* Vs = (u16*)(smem + ATT_VS_OFF);
  const int tid = threadIdx.x, lane = tid & 63, r = lane & 31, h = lane >> 5;
  bf16x8 qf[4];
#pragma unroll
  for (int ks = 0; ks < 4; ++ks) qf[ks] = *(const bf16x8*)&Qw[(size_t)r * ldq + ks * 16 + h * 8];
  u32x4 kreg[KPT], vreg[VPT];
  auto gload = [&](int t) {
#pragma unroll
    for (int i = 0; i < KPT; ++i) { const int c = tid + i * NT; kreg[i] = *(const u32x4*)&Kg[(size_t)(t * KT + (c >> 3)) * ldk + (c & 7) * 8]; }
#pragma unroll
    for (int i = 0; i < VPT; ++i) { const int c = tid + i * NT; vreg[i] = *(const u32x4*)&Vt[(size_t)(c / VCH) * S + t * KT + (c % VCH) * 8]; }
  };
  auto sstore = [&](int buf) {
#pragma unroll
    for (int i = 0; i < KPT; ++i) { const int c = tid + i * NT; *(u32x4*)&Ks[buf * KT * LDK + (c >> 3) * LDK + (c & 7) * 8] = kreg[i]; }
#pragma unroll
    for (int i = 0; i < VPT; ++i) {
      const int c = tid + i * NT; const int row = c / VCH, col = c % VCH;
      *(u32x4*)&Vs[buf * 64 * LDV + row * LDV + col * 8] = vreg[i];
    }
  };
  auto compute = [&](int buf) {
    const u16* ks_ = Ks + buf * KT * LDK + r * LDK + h * 8;
    const u16* vs_ = Vs + buf * 64 * LDV + r * LDV + h * 8;
#pragma unroll 2
    for (int kb = 0; kb < KT / 32; ++kb) {
      bf16x8 pf0[2], pf1[2];
      {
        f32x16 s0;
#pragma unroll
        for (int q = 0; q < 16; ++q) s0[q] = 0.f;
        s0 = mfma(*(const bf16x8*)(ks_ + kb * 32 * LDK + 0), qf[0], s0);
        s0 = mfma(*(const bf16x8*)(ks_ + kb * 32 * LDK + 16), qf[1], s0);
        float sum = 0.f;
#pragma unroll
        for (int q = 0; q < 16; ++q) { s0[q] = __builtin_amdgcn_exp2f(s0[q]); sum += s0[q]; }
        l0 += sum;
#pragma unroll
        for (int sx = 0; sx < 2; ++sx) {
          u32x4 w = {cvtpk(s0[sx * 8 + 0], s0[sx * 8 + 1]), cvtpk(s0[sx * 8 + 2], s0[sx * 8 + 3]),
                     cvtpk(s0[sx * 8 + 4], s0[sx * 8 + 5]), cvtpk(s0[sx * 8 + 6], s0[sx * 8 + 7])};
          pf0[sx] = __builtin_bit_cast(bf16x8, w);
        }
      }
      {
        f32x16 s1;
#pragma unroll
        for (int q = 0; q < 16; ++q) s1[q] = 0.f;
        s1 = mfma(*(const bf16x8*)(ks_ + kb * 32 * LDK + 32), qf[2], s1);
        s1 = mfma(*(const bf16x8*)(ks_ + kb * 32 * LDK + 48), qf[3], s1);
        float sum = 0.f;
#pragma unroll
        for (int q = 0; q < 16; ++q) { s1[q] = __builtin_amdgcn_exp2f(s1[q]); sum += s1[q]; }
        l1 += sum;
#pragma unroll
        for (int sx = 0; sx < 2; ++sx) {
          u32x4 w = {cvtpk(s1[sx * 8 + 0], s1[sx * 8 + 1]), cvtpk(s1[sx * 8 + 2], s1[sx * 8 + 3]),
                     cvtpk(s1[sx * 8 + 4], s1[sx * 8 + 5]), cvtpk(s1[sx * 8 + 6], s1[sx * 8 + 7])};
          pf1[sx] = __builtin_bit_cast(bf16x8, w);
        }
      }
#pragma unroll
      for (int db = 0; db < 2; ++db)
#pragma unroll
        for (int sx = 0; sx < 2; ++sx) {
          bf16x8 vf = *(const bf16x8*)(vs_ + db * 32 * LDV + (kb * 2 + sx) * 16);
          O0[db] = mfma(vf, pf0[sx], O0[db]);
          O1[db] = mfma(vf, pf1[sx], O1[db]);
        }
    }
  };
  gload(0); sstore(0);
  __syncthreads();
#pragma unroll 1
  for (int t = 0; t < ntiles; ++t) {
    if (t + 1 < ntiles) gload(t + 1);
    compute(t & 1);
    if (t + 1 < ntiles) sstore((t + 1) & 1);
    __syncthreads();
  }
}

__device__ __forceinline__ void zeroO(f32x16 (&O)[2], float& ls) {
#pragma unroll
  for (int a = 0; a < 2; ++a)
#pragma unroll
    for (int q = 0; q < 16; ++q) O[a][q] = 0.f;
  ls = 0.f;
}

__device__ __forceinline__ void write_gated(u16* __restrict__ mix, size_t tok, int col0, const f32x16 (&O)[2], int h) {
  u16* rowp = mix + tok * 1024 + col0;
#pragma unroll
  for (int db = 0; db < 2; ++db)
#pragma unroll
    for (int g = 0; g < 4; ++g) {
      u16* ptr = rowp + db * 32 + 8 * g + 4 * h;
      u32x2 gv = *(const u32x2*)ptr;
      u32x2 ov = {cvtpk(O[db][4 * g + 0] * bflo(gv[0]), O[db][4 * g + 1] * bfhi(gv[0])),
                  cvtpk(O[db][4 * g + 2] * bflo(gv[1]), O[db][4 * g + 3] * bfhi(gv[1]))};
      *(u32x2*)ptr = ov;
    }
}

#ifndef ATT_ONLY
#define ATT_ONLY -1
#endif
#define ATT_SEL(i) (ATT_ONLY < 0 || ATT_ONLY == (i))
__device__ __forceinline__ void phase_attn(const Params& p, int l, char* smem, bool dry) {
  const u16* proj = (const u16*)(p.ws + OFF_PROJ);
  const u16* qraw = (const u16*)(p.ws + OFF_A);
  const u16* kmla = (const u16*)(p.ws + OFF_KMLA);
  u16* mix = (u16*)(p.ws + OFF_MIX);
  const int tid = threadIdx.x, lane = tid & 63, wave = tid >> 6, r = lane & 31, h = lane >> 5;
  const float lam = ((const float*)(p.ws + OFF_LAM))[l];
  const float lam_init = (l == 0) ? 0.2f : 0.35550906759096927f;
  float* bias_lds = (float*)(smem + ATT_LDS_END);
  constexpr int N_DIFF = 32 * 16, N_MLA = 48 * 16, N_NA = 48 * 16;
  if (ATT_SEL(0))
#pragma unroll 1
  for (int item = vblock(); item < N_DIFF; item += gridDim.x) {
    f32x16 O[2]; float ls;
    {
      const int bh = item >> 4, qt = item & 15;
      const int b = bh >> 2, hd = bh & 3;
      const size_t tok = (size_t)b * S + qt * 256 + wave * 32 + r;
      const size_t tokw = tok - r;
      const u16* Vt = (const u16*)(p.ws + OFF_VD) + (size_t)(b * 4 + hd) * 64 * S;
      f32x16 O1[2]; float ls1;
      zeroO(O, ls); zeroO(O1, ls1);
      diff_pass<64>(proj + tokw * NPS + C_DQ + hd * 64, NPS, proj + (size_t)b * S * NPS + C_DK + hd * 64, NPS, Vt, S / 64, smem, O, O1, ls, ls1);
      const float* sg = p.subln_g + l * 64;
      {
        const float lt0 = ls + __shfl_xor(ls, 32);
        const float lt1 = ls1 + __shfl_xor(ls1, 32);
        const float inv0 = 1.f / lt0;
        const float inv1 = lam / lt1;
        float ss = 0.f;
#pragma unroll
        for (int db = 0; db < 2; ++db)
#pragma unroll
          for (int q = 0; q < 16; ++q) { float o = O[db][q] * inv0 - O1[db][q] * inv1; O[db][q] = o; ss += o * o; }
        ss += __shfl_xor(ss, 32);
        const float rr = rsqrtf(ss * (1.f / 64.f) + EPS) * (1.f - lam_init);
#pragma unroll
        for (int db = 0; db < 2; ++db)
#pragma unroll
          for (int q = 0; q < 16; ++q) O[db][q] *= rr * sg[db * 32 + crow(q, h)];
      }
      if (!dry) write_gated(mix, tok, 768 + hd * 64, O, h);
    }
  }
  if (ATT_SEL(1))
#pragma unroll 1
  for (int it = vblock(); it < N_MLA; it += gridDim.x) {
    f32x16 O[2]; float ls;
    {
      const int bh = it >> 4, qt = it & 15;
      const int b = bh / 6, hh = bh % 6;
      const size_t tok = (size_t)b * S + qt * 256 + wave * 32 + r;
      const size_t tokw = tok - r;
      zeroO(O, ls);
      attn_pass<96, false, 64>(qraw + tokw * 576 + hh * 96, 576, kmla + (size_t)(b * 6 + hh) * S * 96, 96,
                           (const u16*)(p.ws + OFF_VMLA) + (size_t)(b * 6 + hh) * 64 * S, S / 64, smem, O, ls, 0, 0, 0, nullptr);
      {
        const float lt = ls + __shfl_xor(ls, 32);
        const float inv = 1.f / lt;
#pragma unroll
        for (int db = 0; db < 2; ++db)
#pragma unroll
          for (int q = 0; q < 16; ++q) O[db][q] *= inv;
      }
      if (!dry) write_gated(mix, tok, hh * 64, O, h);
    }
  }
  if (ATT_SEL(2))
#pragma unroll 1
  for (int it = vblock(); it < N_NA; it += gridDim.x) {
    f32x16 O[2]; float ls;
    {
      const int bh = it >> 4, rg = it & 15;
      const int b = bh / 6, hh = bh % 6;
      for (int i = tid; i < 15 * 31; i += NT) bias_lds[i] = p.na_rpb[((size_t)l * 6 + hh) * 465 + i] * LOG2E;
      const int rq = rg * 4 + (wave >> 1);
      const int cbase = (wave & 1) * 32;
      const int kr_lo = min(max(rg * 4 - 4, 0), 56);
      const int kr_hi = min(max(rg * 4 + 3 - 4, 0), 56) + 7;
      const int ntiles = kr_hi - kr_lo + 1;
      const size_t tokw = (size_t)b * S + rq * 64 + cbase;
      const size_t tok = tokw + r;
      zeroO(O, ls);
      attn_pass<64, true, 64>(proj + tokw * NPS + C_NAQ + hh * 64, NPS, proj + ((size_t)b * S + kr_lo * 64) * NPS + C_NAK + hh * 64, NPS,
                          (const u16*)(p.ws + OFF_VNA) + (size_t)(b * 6 + hh) * 64 * S + kr_lo * 64, ntiles, smem, O, ls, rq, kr_lo, cbase, bias_lds);
      {
        const float lt = ls + __shfl_xor(ls, 32);
        const float inv = 1.f / lt;
#pragma unroll
        for (int db = 0; db < 2; ++db)
#pragma unroll
          for (int q = 0; q < 16; ++q) O[db][q] *= inv;
      }
      if (!dry) write_gated(mix, tok, 384 + hh * 64, O, h);
    }
  }
}


#define XB_TMO      128
#define XB_XCNT(j)  (256  + 64 * (j))
#define XB_XSUB(j)  (1280 + 64 * (j))
#define XB_XGEN(j)  (2304 + 64 * (j))
#define XB_TOP      3328
#define XB_TOPGEN   3392
#define XCD_BAR_WORDS 3456
#define XB_SPIN_CAP (1u << 22)
__device__ __forceinline__ unsigned xb_ld(unsigned* p)              { return __hip_atomic_load(p, __ATOMIC_RELAXED, __HIP_MEMORY_SCOPE_AGENT); }
__device__ __forceinline__ unsigned xb_add(unsigned* p, unsigned v) { return __hip_atomic_fetch_add(p, v, __ATOMIC_RELAXED, __HIP_MEMORY_SCOPE_AGENT); }
__device__ __forceinline__ unsigned xb_xcc_id() { return (unsigned)__builtin_amdgcn_s_getreg((3 << 11) | 20) & 0xFu; }
#define XB_SPIN(cond, bar) do { unsigned _sp = 0; while (cond) { __builtin_amdgcn_s_sleep(1); \
    if ((++_sp & 255u) == 0u) { if (xb_ld(&(bar)[XB_TMO])) break; if (_sp > XB_SPIN_CAP) { atomicAdd(&(bar)[XB_TMO], 1u); break; } } } } while (0)
struct XcdBarrier { unsigned* bar; unsigned x; volatile LAS unsigned* st; };
__device__ __forceinline__ XcdBarrier xcd_barrier_post(unsigned* bar, volatile LAS unsigned* st, unsigned& rank) {
  XcdBarrier b; b.bar = bar; b.x = xb_xcc_id(); b.st = st;
  rank = 0u;
  if (threadIdx.x == 0) rank = xb_add(&bar[XB_XCNT(b.x)], 1u);
  return b;
}
__device__ __forceinline__ void xcd_barrier_complete(unsigned* bar, unsigned x, unsigned& nloc, unsigned& nx) {
  const unsigned G = gridDim.x * gridDim.y * gridDim.z;
  unsigned sum, cnt, mine, sp = 0u;
  for (;;) {
    sum = 0u; cnt = 0u; mine = 0u;
#pragma unroll
    for (unsigned j = 0; j < 16; ++j) { const unsigned c = xb_ld(&bar[XB_XCNT(j)]); sum += c; cnt += (c > 0u) ? 1u : 0u; mine = (j == x) ? c : mine; }
    if (sum == G) break;
    __builtin_amdgcn_s_sleep(1);
    if ((++sp & 255u) == 0u) { if (xb_ld(&bar[XB_TMO])) break; if (sp > XB_SPIN_CAP) { atomicAdd(&bar[XB_TMO], 1u); break; } }
  }
  nloc = mine > 0u ? mine : 1u; nx = cnt > 0u ? cnt : 1u;
}
__device__ __forceinline__ void xcd_barrier(const XcdBarrier& b) {
  asm volatile("s_waitcnt vmcnt(0)" ::: "memory");
  __syncthreads();
  if (threadIdx.x == 0) {
    unsigned* bar = b.bar;
    __builtin_amdgcn_s_waitcnt(0);
    unsigned nloc = b.st[0], nx = b.st[1];
    if (nloc == 0u) { xcd_barrier_complete(bar, b.x, nloc, nx); b.st[0] = nloc; b.st[1] = nx; }
    const unsigned old = xb_add(&bar[XB_XSUB(b.x)], 1u);
    const unsigned gen = old / nloc;
    if (old + 1u == (gen + 1u) * nloc) {
      __builtin_amdgcn_fence(__ATOMIC_RELEASE, "agent");
      asm volatile("s_waitcnt vmcnt(0)" ::: "memory");
      const unsigned og = xb_add(&bar[XB_TOP], 1u);
      const unsigned tg = og / nx;
      if (og + 1u == (tg + 1u) * nx) xb_add(&bar[XB_TOPGEN], 1u);
      else XB_SPIN(xb_ld(&bar[XB_TOPGEN]) == tg, bar);
      __builtin_amdgcn_fence(__ATOMIC_ACQUIRE, "agent");
      xb_add(&bar[XB_XGEN(b.x)], 1u);
      asm volatile("s_waitcnt vmcnt(0)" ::: "memory");
    } else {
      XB_SPIN(xb_ld(&bar[XB_XGEN(b.x)]) == gen, bar);
      __builtin_amdgcn_fence(__ATOMIC_ACQUIRE, "agent");
      asm volatile("s_waitcnt vmcnt(0)" ::: "memory");
    }
  }
  __syncthreads();
}

__device__ __forceinline__ void set_vblock(const XcdBarrier& b, unsigned rank) {
  if (threadIdx.x == 0) {
    unsigned pre = 0u, tot = 0u;
#pragma unroll
    for (unsigned j = 0; j < 16; ++j) { const unsigned c = xb_ld(&b.bar[XB_XCNT(j)]); pre += (j < b.x) ? c : 0u; tot += c; }
    s_vb = (tot == gridDim.x) ? (int)(pre + rank) : (int)blockIdx.x;
  }
  __syncthreads();
}

#ifndef ONLY
#define ONLY -1
#endif
template <int PH>
__device__ __forceinline__ void run_phase(const Params& p, char* smem) {
  if (PH == 0) { if (ONLY < 0 || ONLY == 9) phase_prep(p, smem); return; }
  constexpr int l = (PH - 1) / 6, sub = (PH - 1) % 6;
  const int nrep = p.reps[sub];
#pragma unroll 1
  for (int rep = 0; rep < nrep; ++rep) {
    const bool dry = rep + 1 < nrep;
    if (sub == 0) { if (ONLY < 0 || ONLY == 0) phase_norm(p, l); }
    else if (sub == 1) { if (ONLY < 0 || ONLY == 1) phase_gemm1(p, l, smem); }
    else if (sub == 2) { if (ONLY < 0 || ONLY == 2) phase_upproj(p, l, smem); }
    else if (sub == 3) { if (ONLY < 0 || ONLY == 3) phase_post(p, l, smem, dry); }
    else if (sub == 4) { if (ONLY < 0 || ONLY == 4) phase_attn(p, l, smem, dry); }
    else { if (ONLY < 0 || ONLY == 5) phase_gemm2(p, l, smem, dry); }
  }
}

__global__ void __launch_bounds__(512, 2) fwd_kernel(Params p) {
  __shared__ __attribute__((aligned(16))) char smem[SMEM_BYTES];
  __shared__ uint4 xb_words;
  if (threadIdx.x == 0) xb_words = make_uint4(0u, 0u, 0u, 0u);
  __syncthreads();
  unsigned xrank;
  XcdBarrier xb = xcd_barrier_post((unsigned*)(p.ws + OFF_BAR), (volatile LAS unsigned*)&xb_words, xrank);
  if (threadIdx.x == 0) s_vb = blockIdx.x;
  if (p.phase_lo < 0) cg::this_grid().sync();
#define STEP(k) if (p.phase_lo <= (k) && (k) < p.phase_hi) { if ((k) > p.phase_lo) { xcd_barrier(xb); if ((k) == 1) set_vblock(xb, xrank); } run_phase<k>(p, smem); }
  STEP(0) STEP(1) STEP(2) STEP(3) STEP(4) STEP(5) STEP(6) STEP(7) STEP(8) STEP(9) STEP(10) STEP(11) STEP(12)
#undef STEP
}

__global__ void fill_kernel(float* o, int n, float v) {
  for (int i = blockIdx.x * blockDim.x + threadIdx.x; i < n; i += gridDim.x * blockDim.x) o[i] = v;
}

extern "C" void kernel_launch(void* const* d_in, const int* in_sizes, int n_in, void* d_out, int out_size, void* d_ws,
                              size_t ws_size, hipStream_t stream) {
  static int grid_blocks = 0;
  if (!grid_blocks) {
    int dev = 0, cus = 0, per_cu = 0;
    (void)hipGetDevice(&dev);
    (void)hipDeviceGetAttribute(&cus, hipDeviceAttributeMultiprocessorCount, dev);
    (void)hipOccupancyMaxActiveBlocksPerMultiprocessor(&per_cu, fwd_kernel, NT, 0);
    if (per_cu > 1) per_cu = 1;
    if (per_cu < 1) per_cu = 1;
    grid_blocks = cus * per_cu;
  }
  if (ws_size < WS_TOTAL) { fill_kernel<<<1024, 256, 0, stream>>>((float*)d_out, out_size, 100.f); return; }
  Params p{};
  const float** f = (const float**)&p;
  for (int i = 0; i < 23; ++i) f[i] = (const float*)d_in[i];
  p.out = (float*)d_out;
  p.ws = (char*)d_ws;
  { const int reps[6] = {REPS}; for (int i = 0; i < 6; ++i) p.reps[i] = reps[i]; }
#if USE_COOP
  (void)hipMemsetAsync((char*)d_ws + OFF_BAR, 0, SZ_BAR, stream);
  p.phase_lo = 0; p.phase_hi = 13;
  void* args[] = {&p};
  hipError_t e = hipLaunchCooperativeKernel((void*)fwd_kernel, dim3(grid_blocks), dim3(NT), args, 0, stream);
  if (e != hipSuccess) fill_kernel<<<1024, 256, 0, stream>>>((float*)d_out, out_size, 1000.f + (float)(int)e);
#else
  for (int ph = 0; ph < 13; ++ph) {
    p.phase_lo = ph; p.phase_hi = ph + 1;
    fwd_kernel<<<dim3(grid_blocks), dim3(NT), 0, stream>>>(p);
  }
#endif
}
```
